# Optimizing an MI355X kernel written in HIP

```python
import math
import jax, jax.numpy as jnp
from jax import lax
import numpy as np

D_MODEL = 4096
BATCH = 4
SEQ = 2048
DEPTH = 1
DEC_BATCH = 128
DEC_SEQ = 8
PAST_LEN = 16384
PAGE_SIZE = 128

N_META = 16
SSM_WIDTH = D_MODEL // 2
SSM_GROUP = 16
SSM_GROUPS = SSM_WIDTH // SSM_GROUP
SSM_STATE = 64
CONV_WIDTH = D_MODEL // 2
CONV_K = 3
D_FF = ((8 * D_MODEL + 3 * 256 - 1) // (3 * 256)) * 256
IN_COLS = SSM_WIDTH + 3 * CONV_WIDTH + 2 * D_MODEL
DT_MIN = 0.001
DT_MAX = 0.1
EPS = 1e-6

kernel_name = 'hybrid_s5_shortconv_decode_step'


def rmsnorm(x, g):
    x32 = x.astype(jnp.float32)
    y = x32 * lax.rsqrt(jnp.mean(x32 * x32, axis=-1, keepdims=True) + EPS)
    return (y * g.astype(jnp.float32)).astype(x.dtype)


def _scan_op(left, right):
    a1, b1 = left
    a2, b2 = right
    return a1 * a2, a2 * b1 + b2


def s5_mixer(u, s0_re, s0_im, lam_re, lam_im, log_dt, b_re, b_im, c_re, c_im, d_skip):
    f32 = jnp.float32
    n, l, _ = u.shape
    u32 = u.astype(f32).reshape(n, l, SSM_GROUPS, SSM_GROUP)
    lam = lax.complex(lam_re.astype(f32), lam_im.astype(f32))
    dt = jnp.exp(log_dt.astype(f32))[:, None]
    lam_bar = jnp.exp(lam * dt)
    b_bar = ((lam_bar - 1.0) / lam)[:, :, None] * lax.complex(b_re.astype(f32), b_im.astype(f32))
    bu = jnp.einsum('nlgh,gph->nlgp', u32.astype(jnp.complex64), b_bar)
    s0 = lax.complex(s0_re.astype(f32), s0_im.astype(f32))
    bu = bu.at[:, 0].add(lam_bar * s0)
    a = jnp.broadcast_to(lam_bar, bu.shape)
    _, s = lax.associative_scan(_scan_op, (a, bu), axis=1)
    c = lax.complex(c_re.astype(f32), c_im.astype(f32))
    y = jnp.real(jnp.einsum('nlgp,ghp->nlgh', s, c)) + d_skip.astype(f32).reshape(SSM_GROUPS, SSM_GROUP) * u32
    s_last = s[:, -1]
    return y.reshape(n, l, SSM_WIDTH), jnp.real(s_last), jnp.imag(s_last)


def short_conv_mixer(h, gate_b, gate_c, conv_state, conv_w):
    l = h.shape[1]
    z = gate_c * h
    zp = jnp.concatenate([conv_state.astype(z.dtype), z], axis=1)
    y = conv_w[0] * zp[:, 0:l]
    for k in range(1, CONV_K):
        y = y + conv_w[k] * zp[:, k:k + l]
    return gate_b * y, zp[:, -(CONV_K - 1):]


def trunk_layer(x, s_re, s_im, conv_state, g_pre_mix, w_in, lam_re, lam_im, log_dt, b_re, b_im,
                c_re, c_im, ssm_d, w_glu_v, w_glu_g, conv_w, w_conv_out, w_o, g_post_mix,
                g_pre_ffn, w_ffn_gate, w_ffn_up, w_ffn_down, g_post_ffn):
    hn = rmsnorm(x, g_pre_mix)
    proj = hn @ w_in
    o1 = SSM_WIDTH
    o2 = o1 + CONV_WIDTH
    o3 = o2 + CONV_WIDTH
    o4 = o3 + CONV_WIDTH
    o5 = o4 + D_MODEL
    u = proj[..., :o1]
    ch = proj[..., o1:o2]
    cb = proj[..., o2:o3]
    cc = proj[..., o3:o4]
    ga = proj[..., o4:o5]
    gb = proj[..., o5:]
    y_ssm, ns_re, ns_im = s5_mixer(u, s_re, s_im, lam_re, lam_im, log_dt, b_re, b_im, c_re, c_im, ssm_d)
    y_ssm = jax.nn.gelu(y_ssm).astype(x.dtype)
    y_a = (y_ssm @ w_glu_v) * jax.nn.sigmoid(y_ssm @ w_glu_g)
    y_conv, n_conv = short_conv_mixer(ch, cb, cc, conv_state, conv_w)
    y_b = y_conv @ w_conv_out
    merged = jax.nn.sigmoid(ga) * y_a + jax.nn.sigmoid(gb) * y_b
    x = x + rmsnorm(merged @ w_o, g_post_mix)
    hf = rmsnorm(x, g_pre_ffn)
    f = (jax.nn.silu(hf @ w_ffn_gate) * (hf @ w_ffn_up)) @ w_ffn_down
    x = x + rmsnorm(f, g_post_ffn)
    return x, ns_re, ns_im, n_conv


def setup_inputs(seed: int = 0) -> dict:
    key = jax.random.key(seed)
    ks = jax.random.split(key, 32)
    f32 = jnp.float32

    def nrm(k, shape, scale):
        return jax.random.normal(k, shape, f32) * scale

    def gain(k, shape):
        return 1.0 + 0.02 * jax.random.normal(k, shape, f32)

    n_idx = jnp.arange(SSM_STATE, dtype=f32)
    lam_im = jnp.broadcast_to(math.pi * n_idx, (DEPTH, SSM_GROUPS, SSM_STATE)) + nrm(ks[8], (DEPTH, SSM_GROUPS, SSM_STATE), 0.01)
    return {
        'x_prompt': nrm(ks[0], (BATCH, SEQ, D_MODEL), 1.0),
        'x_sample': nrm(ks[1], (DEC_BATCH, DEC_SEQ, D_MODEL), 1.0),
        'state_ssm_re': nrm(ks[2], (DEPTH, DEC_BATCH, SSM_GROUPS, SSM_STATE), 0.1),
        'state_ssm_im': nrm(ks[3], (DEPTH, DEC_BATCH, SSM_GROUPS, SSM_STATE), 0.1),
        'state_conv': nrm(ks[4], (DEPTH, DEC_BATCH, CONV_K - 1, CONV_WIDTH), 1.0),
        'meta_tokens': nrm(ks[5], (N_META, D_MODEL), 1.0),
        'g_pre_mix': gain(ks[6], (DEPTH, D_MODEL)),
        'w_in': nrm(ks[7], (DEPTH, D_MODEL, IN_COLS), D_MODEL ** -0.5),
        'ssm_lambda_re': -0.5 + nrm(ks[9], (DEPTH, SSM_GROUPS, SSM_STATE), 0.01),
        'ssm_lambda_im': lam_im,
        'ssm_log_dt': jax.random.uniform(ks[10], (DEPTH, SSM_GROUPS), f32, math.log(DT_MIN), math.log(DT_MAX)),
        'ssm_b_re': nrm(ks[11], (DEPTH, SSM_GROUPS, SSM_STATE, SSM_GROUP), (2 * SSM_GROUP) ** -0.5),
        'ssm_b_im': nrm(ks[12], (DEPTH, SSM_GROUPS, SSM_STATE, SSM_GROUP), (2 * SSM_GROUP) ** -0.5),
        'ssm_c_re': nrm(ks[13], (DEPTH, SSM_GROUPS, SSM_GROUP, SSM_STATE), (2 * SSM_STATE) ** -0.5),
        'ssm_c_im': nrm(ks[14], (DEPTH, SSM_GROUPS, SSM_GROUP, SSM_STATE), (2 * SSM_STATE) ** -0.5),
        'ssm_d': nrm(ks[15], (DEPTH, SSM_WIDTH), 1.0),
        'w_glu_v': nrm(ks[16], (DEPTH, SSM_WIDTH, D_MODEL), SSM_WIDTH ** -0.5),
        'w_glu_g': nrm(ks[17], (DEPTH, SSM_WIDTH, D_MODEL), SSM_WIDTH ** -0.5),
        'conv_w': nrm(ks[18], (DEPTH, CONV_K, CONV_WIDTH), CONV_K ** -0.5),
        'w_conv_out': nrm(ks[19], (DEPTH, CONV_WIDTH, D_MODEL), CONV_WIDTH ** -0.5),
        'w_o': nrm(ks[20], (DEPTH, D_MODEL, D_MODEL), D_MODEL ** -0.5),
        'g_post_mix': gain(ks[21], (DEPTH, D_MODEL)),
        'g_pre_ffn': gain(ks[22], (DEPTH, D_MODEL)),
        'w_ffn_gate': nrm(ks[23], (DEPTH, D_MODEL, D_FF), D_MODEL ** -0.5),
        'w_ffn_up': nrm(ks[24], (DEPTH, D_MODEL, D_FF), D_MODEL ** -0.5),
        'w_ffn_down': nrm(ks[25], (DEPTH, D_FF, D_MODEL), D_FF ** -0.5),
        'g_post_ffn': gain(ks[26], (DEPTH, D_MODEL)),
    }


def reference(x_prompt, x_sample, state_ssm_re, state_ssm_im, state_conv, meta_tokens, g_pre_mix, w_in,
              ssm_lambda_re, ssm_lambda_im, ssm_log_dt, ssm_b_re, ssm_b_im, ssm_c_re, ssm_c_im, ssm_d,
              w_glu_v, w_glu_g, conv_w, w_conv_out, w_o, g_post_mix, g_pre_ffn, w_ffn_gate, w_ffn_up,
              w_ffn_down, g_post_ffn):
    nb = x_prompt.shape[0]
    meta = jnp.broadcast_to(meta_tokens.astype(x_prompt.dtype)[None], (nb, N_META, D_MODEL))
    xp = jnp.concatenate([meta, x_prompt], axis=1)
    xs = x_sample
    zero_s = jnp.zeros((nb, SSM_GROUPS, SSM_STATE), jnp.float32)
    zero_c = jnp.zeros((nb, CONV_K - 1, CONV_WIDTH), xp.dtype)
    p_re, p_im, p_cv, s_re, s_im, s_cv = [], [], [], [], [], []
    for i in range(DEPTH):
        lw = (g_pre_mix[i], w_in[i], ssm_lambda_re[i], ssm_lambda_im[i], ssm_log_dt[i], ssm_b_re[i],
              ssm_b_im[i], ssm_c_re[i], ssm_c_im[i], ssm_d[i], w_glu_v[i], w_glu_g[i], conv_w[i],
              w_conv_out[i], w_o[i], g_post_mix[i], g_pre_ffn[i], w_ffn_gate[i], w_ffn_up[i],
              w_ffn_down[i], g_post_ffn[i])
        xp, a_re, a_im, a_cv = trunk_layer(xp, zero_s, zero_s, zero_c, *lw)
        xs, b_re, b_im, b_cv = trunk_layer(xs, state_ssm_re[i], state_ssm_im[i], state_conv[i], *lw)
        p_re.append(a_re)
        p_im.append(a_im)
        p_cv.append(a_cv)
        s_re.append(b_re)
        s_im.append(b_im)
        s_cv.append(b_cv)
    y_prompt = xp[:, N_META:]
    return (y_prompt, xs, jnp.stack(p_re), jnp.stack(p_im), jnp.stack(p_cv),
            jnp.stack(s_re), jnp.stack(s_im), jnp.stack(s_cv))
```

```cpp
#include <hip/hip_runtime.h>
#include <cstdio>
#include <cstdint>
#define MK_N_LAUNCHES 1
namespace pg8 {
#define PG8_LAS __attribute__((address_space(3)))
typedef unsigned short bf16_t;
typedef short bf16x8 __attribute__((ext_vector_type(8)));
typedef float f32x4 __attribute__((ext_vector_type(4)));
typedef unsigned u32x4 __attribute__((ext_vector_type(4)));
constexpr int BM = 256, BK = 64, HALF = 128, HTB = HALF * BK * 2  , STAGE_BYTES = 8 * HTB, NXCD = 8, WGM = 8;

__host__ __device__ __forceinline__ int lds_byte(int r, int c) { const int st = (r >> 4) * 2 + (c >> 5), rr = r & 15, cc = c & 31, ob = rr * 64 + cc * 2; return st * 1024 + (ob ^ (((ob >> 9) & 1) << 5)); }
__host__ __device__ __forceinline__ void stage_rc(int b, int& R, int& C) { const int st = b / 1024, sb = b % 1024, swz = sb ^ (((sb >> 9) & 1) << 5); R = (st >> 1) * 16 + swz / 64; C = (st & 1) * 32 + (swz % 64) / 2; }
__host__ __device__ __forceinline__ int perm32(int rho) { const int n = rho >> 4, i = rho & 15; return 8 * (i >> 2) + 4 * n + (i & 3); }

struct Unit { int pm, pn, kt0, nkt, part; };
struct Gemm { const bf16_t* A; const bf16_t* Bt; int M, N, K; };

__device__ __forceinline__ long long pack_unit(int pm, int pn, int part, int kt0, int nkt) { return (long long)(unsigned)(pm | (pn << 8) | (part << 16) | (kt0 << 20)) | ((long long)nkt << 32); }
__device__ __forceinline__ Unit unpack_unit(long long d) { const unsigned lo = (unsigned)d; Unit u; u.pm = lo & 255; u.pn = (lo >> 8) & 255; u.part = (lo >> 16) & 15; u.kt0 = lo >> 20; u.nkt = (int)(d >> 32); return u; }
template <int M_, int N_, int K_> struct StaticOrderT {
    static constexpr int nM = M_ / BM, nN = N_ / BM, nwg = nM * nN, nktf = K_ / BK, WG = (nM % 6 == 0) ? 6 : WGM;
    int G, c;
    __device__ __forceinline__ void init(int G_, int c_) { G = G_; c = c_; }
    __device__ __forceinline__ long long next(int i) const { const int L = i * G + c; return L >= nwg ? -1ll : map(L); }
    __device__ __forceinline__ int max_units() const { return (nwg + G - 1) / G; }
    __device__ __forceinline__ static long long map(int L) {
        int wgid = L; { constexpr int q = nwg / NXCD, r = nwg % NXCD; const int xcd = wgid % NXCD, off = wgid / NXCD; wgid = (xcd < r ? xcd * (q + 1) : r * (q + 1) + (xcd - r) * q) + off; }
        constexpr int nig = WG * nN; const int gid = wgid / nig, fm = gid * WG, gsz = (nM - fm) < WG ? (nM - fm) : WG;
        return pack_unit(fm + ((wgid % nig) % gsz), (wgid % nig) / gsz, 0, 0, nktf);
    }
};
template <int MW_, int M_, int N_, int K_, int SPLIT> struct TailSplitOrderT {
    typedef StaticOrderT<MW_, N_, K_> WO;
    static constexpr int nMw = MW_ / BM, nN = N_ / BM, nTail = (M_ - MW_) / BM * nN, np = K_ / BK / 2, base = np / SPLIT, rem = np % SPLIT;
    WO W; int nwhole;
    __device__ __forceinline__ void init(int G_, int c_) { W.init(G_, c_); nwhole = c_ < WO::nwg ? (WO::nwg - c_ + G_ - 1) / G_ : 0; }
    __device__ __forceinline__ long long next(int i) const {
        if (i < nwhole) return W.next(i);
        if (i != nwhole || W.c >= nTail * SPLIT) return -1ll;
        const int part = W.c % SPLIT, tu = W.c / SPLIT;
        return pack_unit(nMw + tu / nN, tu % nN, part, 2 * (part * base + (part < rem ? part : rem)), 2 * (base + (part < rem ? 1 : 0)));
    }
    __device__ __forceinline__ int max_units() const { return W.max_units() + 1; }
};
template <int M_, int N_, int K_, int SPLIT, int GRID> struct RoundsTailOrderT {
    typedef StaticOrderT<M_, N_, K_> WO;
    static constexpr int R = WO::nwg / GRID, nTail = WO::nwg % GRID, nkp = K_ / BK / SPLIT;
    static_assert(nTail * SPLIT <= GRID && nkp % 2 == 0 && nkp >= 2 && nkp * SPLIT * BK == K_, "RoundsTailOrderT geometry");
    int c;
    __device__ __forceinline__ void init(int c_) { c = c_; }
    __device__ __forceinline__ long long next(int i) const {
        if (i < R) return WO::map(i * GRID + c);
        if (i != R || c >= nTail * SPLIT) return -1ll;
        const Unit u = unpack_unit(WO::map(R * GRID + c / SPLIT)); const int part = c % SPLIT;
        return pack_unit(u.pm, u.pn, 1 + part, part * nkp, nkp);
    }
    __device__ __forceinline__ int max_units() const { return R + (nTail ? 1 : 0); }
};
__device__ __forceinline__ unsigned cvt_pk_bf16(float lo, float hi) { unsigned r; asm volatile("v_cvt_pk_bf16_f32 %0, %1, %2" : "=v"(r) : "v"(lo), "v"(hi)); return r; }
typedef float f32x2 __attribute__((ext_vector_type(2)));
struct NoHook { __device__ __forceinline__ void operator()() const {} };
typedef int i32x4 __attribute__((ext_vector_type(4)));
template <bool I8> __device__ __forceinline__ f32x4 mma1(bf16x8 b, bf16x8 a, f32x4 c) {
    if constexpr (I8) return __builtin_bit_cast(f32x4, __builtin_amdgcn_mfma_i32_16x16x64_i8(__builtin_bit_cast(i32x4, b), __builtin_bit_cast(i32x4, a), __builtin_bit_cast(i32x4, c), 0, 0, 0));
    else return __builtin_amdgcn_mfma_f32_16x16x32_bf16(b, a, c, 0, 0, 0);
}
template <class Epi, class Sched, bool ALIGN_EPI = false, bool SP2 = false, class Hook = NoHook, bool I8 = false>
__device__ __forceinline__ void gemm_phase(PG8_LAS unsigned char* lds, const Gemm g, const Sched& S, const Epi& E, const Hook& hook = Hook()) {
    const int tid = threadIdx.x, wid = __builtin_amdgcn_readfirstlane(tid >> 6), lane = tid & 63, wr = wid >> 2, wc = wid & 3, fr = lane & 15, fq = lane >> 4;
    const int K = g.K;
    unsigned voffA[2], voffB[2];
#pragma unroll
    for (int i = 0; i < 2; ++i) { int R, C; stage_rc(tid * 16 + i * 8192, R, C); const int Rb = Epi::PERM ? ((R & ~31) + perm32(R & 31)) : R;
        voffA[i] = (unsigned)(R * K + C) * 2u; voffB[i] = (unsigned)(Rb * K + C) * 2u; }
    const size_t kstep = (size_t)(BK * 2);
    const size_t hstep = (size_t)HALF * K * 2;
    const size_t tstep = 2 * hstep;
    const unsigned ldsw = (unsigned)wid * 1024u;
    const int aoff = lds_byte(wr * 64 + fr, fq * 8), boff = lds_byte(wc * 32 + fr, fq * 8);
#define PG8_SA(b, h) (((b) * 2 + (h)) * HTB)
#define PG8_SB(b, h) ((4 + (b) * 2 + (h)) * HTB)
#define PG8_STAGE(bufoff, gbase, voff) do { _Pragma("unroll") for (int _i = 0; _i < 2; ++_i) \
        __builtin_amdgcn_global_load_lds((const unsigned*)((const char*)(gbase) + (voff)[_i]), (PG8_LAS unsigned*)(lds + (bufoff) + ldsw + _i * 8192), 16, 0, 0); } while (0)
#define PG8_LDA(dst, b, h) do { _Pragma("unroll") for (int m = 0; m < 4; ++m) _Pragma("unroll") for (int k = 0; k < 2; ++k) dst[m][k] = *(const PG8_LAS bf16x8*)(lds + PG8_SA(b, h) + aoff + m * 2048 + k * 1024); } while (0)
#define PG8_LDB(dst, b, h) do { _Pragma("unroll") for (int n = 0; n < 2; ++n) _Pragma("unroll") for (int k = 0; k < 2; ++k) dst[n][k] = *(const PG8_LAS bf16x8*)(lds + PG8_SB(b, h) + boff + n * 2048 + k * 1024); } while (0)
#define PG8_MMA(ai, bj, At, Bt) do { __builtin_amdgcn_s_setprio(1); _Pragma("unroll") for (int k = 0; k < 2; ++k) _Pragma("unroll") for (int m = 0; m < 4; ++m) _Pragma("unroll") for (int n = 0; n < 2; ++n) \
        acc[ai][bj][m][n] = mma1<I8>(Bt[n][k], At[m][k], acc[ai][bj][m][n]); __builtin_amdgcn_s_setprio(0); } while (0)
#define PG8_WAIT_V(n) asm volatile("s_waitcnt vmcnt(" #n ")" ::: "memory")
#define PG8_WAIT_L(n) asm volatile("s_waitcnt lgkmcnt(" #n ")" ::: "memory")
#define PG8_BAR __builtin_amdgcn_s_barrier()
#define PG8_SCHED __builtin_amdgcn_sched_barrier(0)
    int ui = 0, c_pm, c_pn, c_kt0, c_nkt, c_part;
    int nhook = S.max_units() - 1;
    { const long long d0 = S.next(0); if (d0 < 0) { for (; nhook > 0; --nhook) hook(); return; } const Unit u0 = unpack_unit(d0); c_pm = u0.pm; c_pn = u0.pn; c_kt0 = u0.kt0; c_nkt = u0.nkt; c_part = u0.part; }
    f32x4 acc[2][2][4][2];
#pragma unroll
    for (int a = 0; a < 2; ++a)
#pragma unroll
        for (int b = 0; b < 2; ++b)
#pragma unroll
            for (int m = 0; m < 4; ++m)
#pragma unroll
                for (int n = 0; n < 2; ++n) acc[a][b][m][n] = (f32x4){0.f, 0.f, 0.f, 0.f};
    bf16x8 At[4][2], B0[2][2], B1[2][2];
    const char* cA = (const char*)g.A + (size_t)c_pm * tstep + (size_t)c_kt0 * kstep; const char* cB = (const char*)g.Bt + (size_t)c_pn * tstep + (size_t)c_kt0 * kstep;
    if constexpr (SP2) {
        PG8_STAGE(PG8_SB(0, 0), cB, voffB); PG8_STAGE(PG8_SB(0, 1), cB + hstep, voffB); PG8_STAGE(PG8_SA(0, 0), cA, voffA); PG8_STAGE(PG8_SA(0, 1), cA + hstep, voffA);
        if (wr == 1) PG8_BAR;
        PG8_WAIT_V(2); PG8_BAR;
        PG8_STAGE(PG8_SB(1, 0), cB + kstep, voffB); PG8_STAGE(PG8_SA(1, 0), cA + kstep, voffA); PG8_STAGE(PG8_SB(1, 1), cB + hstep + kstep, voffB);
        PG8_WAIT_V(6); PG8_BAR;
    } else {
        PG8_STAGE(PG8_SB(0, 0), cB, voffB); PG8_STAGE(PG8_SA(0, 0), cA, voffA); PG8_STAGE(PG8_SB(0, 1), cB + hstep, voffB); PG8_STAGE(PG8_SA(0, 1), cA + hstep, voffA);
        if (wr == 1) PG8_BAR;
        PG8_WAIT_V(4); PG8_BAR;
        PG8_STAGE(PG8_SB(1, 0), cB + kstep, voffB); PG8_STAGE(PG8_SA(1, 0), cA + kstep, voffA); PG8_STAGE(PG8_SB(1, 1), cB + hstep + kstep, voffB);
        PG8_WAIT_V(6); PG8_BAR;
    }
    for (;;) {
        bool has_next; const char* nA; const char* nB;
        { const long long dn = S.next(ui + 1); has_next = dn >= 0; const Unit nxt = unpack_unit(dn);
          nA = has_next ? (const char*)g.A + (size_t)nxt.pm * tstep + (size_t)nxt.kt0 * kstep : cA; nB = has_next ? (const char*)g.Bt + (size_t)nxt.pn * tstep + (size_t)nxt.kt0 * kstep : cB; }
        const int nt = c_nkt;
        for (int t = 0; t < nt; t += 2) {
            const bool last = (t == nt - 2);
            const char* a1 = cA + (size_t)(t + 1) * kstep;
            const char* a2 = last ? nA : cA + (size_t)(t + 2) * kstep; const char* b2 = last ? nB : cB + (size_t)(t + 2) * kstep;
            const char* a3 = a2 + kstep; const char* b3 = b2 + kstep;
            if constexpr (SP2) {
            PG8_LDB(B0, 0, 0); PG8_LDB(B1, 0, 1); PG8_SCHED; PG8_LDA(At, 0, 0); PG8_STAGE(PG8_SA(1, 1), a1 + hstep, voffA);
            PG8_WAIT_V(8); PG8_WAIT_L(0); PG8_BAR; PG8_MMA(0, 0, At, B0); PG8_MMA(0, 1, At, B1); PG8_BAR; PG8_SCHED;
            PG8_LDA(At, 0, 1); PG8_STAGE(PG8_SB(0, 0), b2, voffB); PG8_STAGE(PG8_SB(0, 1), b2 + hstep, voffB); PG8_STAGE(PG8_SA(0, 0), a2, voffA);
            PG8_WAIT_V(8); PG8_WAIT_L(0); PG8_BAR; PG8_MMA(1, 0, At, B0); PG8_MMA(1, 1, At, B1); PG8_BAR; PG8_SCHED;
            PG8_LDB(B0, 1, 0); PG8_LDB(B1, 1, 1); PG8_SCHED; PG8_LDA(At, 1, 0); PG8_STAGE(PG8_SA(0, 1), a2 + hstep, voffA);
            PG8_WAIT_V(8); PG8_WAIT_L(0); PG8_BAR; PG8_MMA(0, 0, At, B0); PG8_MMA(0, 1, At, B1); PG8_BAR; PG8_SCHED;
            PG8_LDA(At, 1, 1); PG8_STAGE(PG8_SB(1, 0), b3, voffB); PG8_STAGE(PG8_SB(1, 1), b3 + hstep, voffB); PG8_STAGE(PG8_SA(1, 0), a3, voffA);
            PG8_WAIT_V(8); PG8_WAIT_L(0); PG8_BAR; PG8_MMA(1, 0, At, B0); PG8_MMA(1, 1, At, B1); PG8_BAR; PG8_SCHED;
            } else {
            PG8_LDB(B0, 0, 0); PG8_SCHED; PG8_LDA(At, 0, 0); PG8_STAGE(PG8_SA(1, 1), a1 + hstep, voffA);
            PG8_WAIT_L(8); PG8_BAR; PG8_WAIT_L(0); PG8_MMA(0, 0, At, B0); PG8_BAR; PG8_SCHED;
            PG8_LDB(B1, 0, 1); PG8_STAGE(PG8_SB(0, 0), b2, voffB);
            PG8_BAR; PG8_WAIT_L(0); PG8_MMA(0, 1, At, B1); PG8_BAR;
            PG8_LDA(At, 0, 1); PG8_STAGE(PG8_SA(0, 0), a2, voffA);
            PG8_BAR; PG8_WAIT_L(0); PG8_MMA(1, 0, At, B0); PG8_BAR; PG8_SCHED;
            PG8_STAGE(PG8_SB(0, 1), b2 + hstep, voffB);
            PG8_WAIT_V(6); PG8_BAR; PG8_MMA(1, 1, At, B1); PG8_BAR;
            PG8_LDB(B0, 1, 0); PG8_SCHED; PG8_LDA(At, 1, 0); PG8_STAGE(PG8_SA(0, 1), a2 + hstep, voffA);
            PG8_WAIT_L(8); PG8_BAR; PG8_WAIT_L(0); PG8_MMA(0, 0, At, B0); PG8_BAR; PG8_SCHED;
            PG8_LDB(B1, 1, 1); PG8_STAGE(PG8_SB(1, 0), b3, voffB);
            PG8_BAR; PG8_WAIT_L(0); PG8_MMA(0, 1, At, B1); PG8_BAR;
            PG8_LDA(At, 1, 1); PG8_STAGE(PG8_SA(1, 0), a3, voffA);
            PG8_BAR; PG8_WAIT_L(0); PG8_MMA(1, 0, At, B0); PG8_BAR; PG8_SCHED;
            PG8_STAGE(PG8_SB(1, 1), b3 + hstep, voffB);
            PG8_WAIT_V(6); PG8_BAR; PG8_MMA(1, 1, At, B1); PG8_BAR;
            }
        }
        if constexpr (ALIGN_EPI) { if (wr == 0) PG8_BAR; }
        if constexpr (I8) {
#pragma unroll
            for (int a = 0; a < 2; ++a)
#pragma unroll
                for (int bq = 0; bq < 2; ++bq)
#pragma unroll
                    for (int m = 0; m < 4; ++m)
#pragma unroll
                        for (int n = 0; n < 2; ++n) acc[a][bq][m][n] = __builtin_convertvector(__builtin_bit_cast(i32x4, acc[a][bq][m][n]), f32x4); }
        if constexpr (!Epi::AFTER_DRAIN) { const Unit cu{c_pm, c_pn, c_kt0, c_nkt, c_part}; E(acc, cu, wr, wc, fr, fq); }
        if (!has_next) break;
        hook(); --nhook;
#pragma unroll
        for (int a = 0; a < 2; ++a)
#pragma unroll
            for (int b = 0; b < 2; ++b)
#pragma unroll
                for (int m = 0; m < 4; ++m)
#pragma unroll
                    for (int n = 0; n < 2; ++n) acc[a][b][m][n] = (f32x4){0.f, 0.f, 0.f, 0.f};
        ++ui; { int uj = ui; asm volatile("" : "+s"(uj)); const Unit u1 = unpack_unit(S.next(uj)); c_pm = u1.pm; c_pn = u1.pn; c_kt0 = u1.kt0; c_nkt = u1.nkt; c_part = u1.part; } cA = nA; cB = nB;
        if constexpr (ALIGN_EPI) { if (wr == 1) PG8_BAR; }
    }
    PG8_WAIT_V(0);
    if constexpr (!ALIGN_EPI) { if (wr == 0) PG8_BAR; }
    PG8_BAR;
    for (; nhook > 0; --nhook) hook();
    if constexpr (Epi::AFTER_DRAIN) { const Unit cu{c_pm, c_pn, c_kt0, c_nkt, c_part}; E.fused(acc, cu, wr, wc, fr, fq, lds, wid, lane); }
#undef PG8_SA
#undef PG8_SB
#undef PG8_STAGE
#undef PG8_LDA
#undef PG8_LDB
#undef PG8_MMA
#undef PG8_WAIT_V
#undef PG8_WAIT_L
#undef PG8_BAR
#undef PG8_SCHED
}
}
namespace pg8 {
typedef unsigned u32x2 __attribute__((ext_vector_type(2)));
__device__ __forceinline__ float bf_lo(unsigned w) { return __uint_as_float(w << 16); }
__device__ __forceinline__ float bf_hi(unsigned w) { return __uint_as_float(w & 0xffff0000u); }
__device__ __forceinline__ float sigm(float x) { return __builtin_amdgcn_rcpf(1.0f + __builtin_amdgcn_exp2f(-1.44269504089f * x)); }
__device__ __forceinline__ f32x4 sigm4(f32x4 v) { return (f32x4){sigm(v[0]), sigm(v[1]), sigm(v[2]), sigm(v[3])}; }
__device__ __forceinline__ u32x4 pack8(f32x4 v0, f32x4 v1) { u32x4 w; w.x = cvt_pk_bf16(v0[0], v0[1]); w.y = cvt_pk_bf16(v0[2], v0[3]); w.z = cvt_pk_bf16(v1[0], v1[1]); w.w = cvt_pk_bf16(v1[2], v1[3]); return w; }
__device__ __forceinline__ void unpack8(u32x4 w, f32x4& v0, f32x4& v1) { v0 = (f32x4){bf_lo(w.x), bf_hi(w.x), bf_lo(w.y), bf_hi(w.y)}; v1 = (f32x4){bf_lo(w.z), bf_hi(w.z), bf_lo(w.w), bf_hi(w.w)}; }

__device__ __forceinline__ unsigned pack4u(f32x4 v) { unsigned w = 0u;
    w = __builtin_amdgcn_cvt_pk_u8_f32(__builtin_rintf(v[0] * 255.0f), 0, w); w = __builtin_amdgcn_cvt_pk_u8_f32(__builtin_rintf(v[1] * 255.0f), 1, w);
    w = __builtin_amdgcn_cvt_pk_u8_f32(__builtin_rintf(v[2] * 255.0f), 2, w); w = __builtin_amdgcn_cvt_pk_u8_f32(__builtin_rintf(v[3] * 255.0f), 3, w); return w; }
__device__ __forceinline__ u32x2 pack8u(f32x4 v0, f32x4 v1) { u32x2 w; w.x = pack4u(v0); w.y = pack4u(v1); return w; }
__device__ __forceinline__ f32x4 unpack4u(unsigned w) { return (f32x4){(float)(w & 255u), (float)((w >> 8) & 255u), (float)((w >> 16) & 255u), (float)(w >> 24)} * (1.0f / 255.0f); }
__device__ __forceinline__ void unpack8u(u32x2 w, f32x4& v0, f32x4& v1) { v0 = unpack4u(w.x); v1 = unpack4u(w.y); }

#ifndef PG8_WT
#define PG8_WT 0
#endif
struct OutBuf { __amdgpu_buffer_rsrc_t r;
    __device__ __forceinline__ OutBuf(const void* base, size_t bytes) : r(__builtin_amdgcn_make_buffer_rsrc((void*)base, (short)0, (int)bytes, 0x00020000)) {}
    __device__ __forceinline__ void st(unsigned voff, unsigned soff, u32x4 v) const { __builtin_amdgcn_raw_buffer_store_b128(v, r, (int)(voff + soff), 0, PG8_WT); }
    __device__ __forceinline__ u32x4 ld(unsigned voff) const { return __builtin_amdgcn_raw_buffer_load_b128(r, (int)voff, 0, 0); }
    __device__ __forceinline__ void st8(unsigned voff, u32x2 v) const { __builtin_amdgcn_raw_buffer_store_b64(v, r, (int)voff, 0, PG8_WT); }
    __device__ __forceinline__ u32x2 ld8(unsigned voff) const { return __builtin_amdgcn_raw_buffer_load_b64(r, (int)voff, 0, 0); }
    __device__ __forceinline__ void stf(unsigned voff, unsigned soff, f32x4 v) const { __builtin_amdgcn_raw_buffer_store_b128(__builtin_bit_cast(u32x4, v), r, (int)(voff + soff), 0, PG8_WT); } };
struct EpiProj {
    static constexpr bool PERM = true, AFTER_DRAIN = false;
    bf16_t *U, *Z, *CB, *SGA, *SGB;
    __device__ __forceinline__ void operator()(const f32x4 (&acc)[2][2][4][2], const Unit& u, int wr, int wc, int fr, int fq) const {
        const int row0 = u.pm * BM + wr * 64 + fr, cw = wc * 32 + 8 * fq, pn = u.pn;
        if (pn >= 8 && pn < 24) {
            const OutBuf ob(Z, (size_t)9216 * 2048 * 2); const unsigned v0 = (unsigned)(row0 * 2048 + (pn - 8) * 128 + cw) * 2u;
#pragma unroll
            for (int ai = 0; ai < 2; ++ai)
#pragma unroll
                for (int m = 0; m < 4; ++m) ob.st(v0, (unsigned)(ai * HALF + m * 16) * 2048u * 2u, pack8(acc[ai][0][m][0] * acc[ai][1][m][0], acc[ai][0][m][1] * acc[ai][1][m][1]));
        } else {
            bf16_t* base; int ldc, cb; bool sg;
            if (pn < 8) { base = U; cb = pn * 256; ldc = 2048; sg = false; }
            else if (pn < 32) { base = CB; cb = (pn - 24) * 256; ldc = 2048; sg = false; }
            else if (pn < 48) { base = SGA; cb = (pn - 32) * 256; ldc = 4096; sg = true; }
            else { base = SGB; cb = (pn - 48) * 256; ldc = 4096; sg = true; }
            const OutBuf ob(base, (size_t)9216 * ldc * 2); const unsigned v0 = (unsigned)(row0 * ldc + cb + cw) * 2u;
#pragma unroll
            for (int ai = 0; ai < 2; ++ai)
#pragma unroll
                for (int m = 0; m < 4; ++m)
#pragma unroll
                    for (int bj = 0; bj < 2; ++bj) { f32x4 v0f = acc[ai][bj][m][0], v1f = acc[ai][bj][m][1];
                        if (sg) { v0f = sigm4(v0f); v1f = sigm4(v1f); }
                        ob.st(v0, (unsigned)((ai * HALF + m * 16) * ldc + bj * HALF) * 2u, pack8(v0f, v1f)); }
        }
    }
};
struct EpiGlu {
    static constexpr bool PERM = true, AFTER_DRAIN = false;
    const bf16_t* SGA; bf16_t* M1;
    __device__ __forceinline__ void operator()(const f32x4 (&acc)[2][2][4][2], const Unit& u, int wr, int wc, int fr, int fq) const {
        const int row0 = u.pm * BM + wr * 64 + fr, col = u.pn * 128 + wc * 32 + 8 * fq; const OutBuf ob(M1, (size_t)9216 * 4096 * 2), ib(SGA, (size_t)9216 * 4096);
#pragma unroll
        for (int ai = 0; ai < 2; ++ai)
#pragma unroll
            for (int m = 0; m < 4; ++m) { const unsigned off = (unsigned)((row0 + ai * HALF + m * 16) * 4096 + col);
                f32x4 s0, s1; unpack8u(ib.ld8(off), s0, s1);
                const f32x4 o0 = s0 * acc[ai][0][m][0] * sigm4(acc[ai][1][m][0]), o1 = s1 * acc[ai][0][m][1] * sigm4(acc[ai][1][m][1]);
                ob.st((unsigned)off * 2u, 0u, pack8(o0, o1)); }
    }
};
struct EpiConvOut {
    static constexpr bool PERM = true, AFTER_DRAIN = false;
    const bf16_t *SGB, *M1; bf16_t* MG; bf16_t* XT; int MW, MT;
    __device__ __forceinline__ void operator()(const f32x4 (&acc)[2][2][4][2], const Unit& u, int wr, int wc, int fr, int fq) const {
        const int row0 = u.pm * BM + wr * 64 + fr, col = u.pn * BM + wc * 32 + 8 * fq; const OutBuf ob(MG, (size_t)9216 * 4096 * 2), ig(SGB, (size_t)9216 * 4096), im(M1, (size_t)9216 * 4096 * 2);
        if (row0 >= MW) {
            const OutBuf xb(XT, (size_t)4 * MT * 4096 * 2); const unsigned v0 = (unsigned)((u.part * MT + (row0 - MW)) * 4096 + col) * 2u;
#pragma unroll
            for (int ai = 0; ai < 2; ++ai)
#pragma unroll
                for (int m = 0; m < 4; ++m)
#pragma unroll
                    for (int bj = 0; bj < 2; ++bj) xb.st(v0, (unsigned)((ai * HALF + m * 16) * 4096 + bj * HALF) * 2u, pack8(acc[ai][bj][m][0], acc[ai][bj][m][1]));
            return;
        }
#pragma unroll
        for (int ai = 0; ai < 2; ++ai)
#pragma unroll
            for (int m = 0; m < 4; ++m)
#pragma unroll
                for (int bj = 0; bj < 2; ++bj) { const unsigned off = (unsigned)((row0 + ai * HALF + m * 16) * 4096 + col + bj * HALF);
                    f32x4 s0, s1, a0, a1; unpack8u(ig.ld8(off), s0, s1); unpack8(im.ld(off * 2u), a0, a1);
                    ob.st((unsigned)off * 2u, 0u, pack8(a0 + s0 * acc[ai][bj][m][0], a1 + s1 * acc[ai][bj][m][1])); }
    }
};
struct EpiBf16Parts {
    static constexpr bool PERM = true, AFTER_DRAIN = false;
    bf16_t* C; bf16_t* XT; int MW, MT;
    __device__ __forceinline__ void operator()(const f32x4 (&acc)[2][2][4][2], const Unit& u, int wr, int wc, int fr, int fq) const {
        const int row0 = u.pm * BM + wr * 64 + fr, col = u.pn * BM + wc * 32 + 8 * fq;
        if (row0 < MW) {
            const OutBuf ob(C, (size_t)9216 * 4096 * 2); const unsigned v0 = (unsigned)(row0 * 4096 + col) * 2u;
#pragma unroll
            for (int ai = 0; ai < 2; ++ai)
#pragma unroll
                for (int m = 0; m < 4; ++m)
#pragma unroll
                    for (int bj = 0; bj < 2; ++bj) ob.st(v0, (unsigned)((ai * HALF + m * 16) * 4096 + bj * HALF) * 2u, pack8(acc[ai][bj][m][0], acc[ai][bj][m][1]));
        } else {
            const OutBuf ob(XT, (size_t)4 * MT * 4096 * 2); const unsigned v0 = (unsigned)((u.part * MT + (row0 - MW)) * 4096 + col) * 2u;
#pragma unroll
            for (int ai = 0; ai < 2; ++ai)
#pragma unroll
                for (int m = 0; m < 4; ++m)
#pragma unroll
                    for (int bj = 0; bj < 2; ++bj) ob.st(v0, (unsigned)((ai * HALF + m * 16) * 4096 + bj * HALF) * 2u, pack8(acc[ai][bj][m][0], acc[ai][bj][m][1]));
        }
    }
};
struct EpiSwiGlu {
    static constexpr bool PERM = true, AFTER_DRAIN = false;
    bf16_t* H; f32x4* XS;
    __device__ __forceinline__ void operator()(const f32x4 (&acc)[2][2][4][2], const Unit& u, int wr, int wc, int fr, int fq) const {
        if (u.part != 0) {
            const OutBuf ob(XS, (size_t)192 * 16 * 512 * 16); const unsigned v0 = ((unsigned)blockIdx.x * 16u * 512u + threadIdx.x) * 16u;
#pragma unroll
            for (int ai = 0; ai < 2; ++ai)
#pragma unroll
                for (int bj = 0; bj < 2; ++bj)
#pragma unroll
                    for (int m = 0; m < 4; ++m) ob.st(v0, (unsigned)(((ai * 2 + bj) * 4 + m) * 8192), pack8(acc[ai][bj][m][0], acc[ai][bj][m][1]));
            return;
        }
        const int row0 = u.pm * BM + wr * 64 + fr, col = u.pn * 128 + wc * 32 + 8 * fq;
        const OutBuf ob(H, (size_t)9216 * 11008 * 2); const unsigned v0 = (unsigned)(row0 * 11008 + col) * 2u;
#pragma unroll
        for (int ai = 0; ai < 2; ++ai)
#pragma unroll
            for (int m = 0; m < 4; ++m) { const f32x4 g0 = acc[ai][0][m][0], g1 = acc[ai][0][m][1];
                ob.st(v0, (unsigned)((ai * HALF + m * 16) * 11008) * 2u, pack8(g0 * sigm4(g0) * acc[ai][1][m][0], g1 * sigm4(g1) * acc[ai][1][m][1])); }
    }
};
struct EpiGateI8 {
    static constexpr bool PERM = true, AFTER_DRAIN = false;
    bf16_t *SGA, *SGB; const float* SA; const float* SB;
    __device__ __forceinline__ void operator()(const f32x4 (&acc)[2][2][4][2], const Unit& u, int wr, int wc, int fr, int fq) const {
        const int row0 = u.pm * BM + wr * 64 + fr, cw = wc * 32 + 8 * fq, cq = u.pn * BM + cw;
        const OutBuf ob(u.pn < 16 ? SGA : SGB, (size_t)9216 * 4096); const unsigned v0 = (unsigned)(row0 * 4096 + (u.pn & 15) * 256 + cw);
        f32x4 sb[2][2];
#pragma unroll
        for (int bj = 0; bj < 2; ++bj) { sb[bj][0] = *(const f32x4*)(SB + cq + bj * HALF); sb[bj][1] = *(const f32x4*)(SB + cq + bj * HALF + 4); }
#pragma unroll
        for (int ai = 0; ai < 2; ++ai)
#pragma unroll
            for (int m = 0; m < 4; ++m) { const float sa = SA[row0 + ai * HALF + m * 16];
#pragma unroll
                for (int bj = 0; bj < 2; ++bj)
                    ob.st8(v0 + (unsigned)((ai * HALF + m * 16) * 4096 + bj * HALF), pack8u(sigm4(acc[ai][bj][m][0] * (sb[bj][0] * sa)), sigm4(acc[ai][bj][m][1] * (sb[bj][1] * sa)))); }
    }
};
struct EpiSwiGluI8 {
    static constexpr bool PERM = true, AFTER_DRAIN = false;
    bf16_t* H; f32x4* XS; const float* SA; const float* SB;
    __device__ __forceinline__ void operator()(const f32x4 (&acc)[2][2][4][2], const Unit& u, int wr, int wc, int fr, int fq) const {
        if (u.part != 0) {
            const OutBuf ob(XS, (size_t)192 * 16 * 512 * 16); const unsigned v0 = ((unsigned)blockIdx.x * 16u * 512u + threadIdx.x) * 16u;
#pragma unroll
            for (int ai = 0; ai < 2; ++ai)
#pragma unroll
                for (int bj = 0; bj < 2; ++bj)
#pragma unroll
                    for (int m = 0; m < 4; ++m) ob.st(v0, (unsigned)(((ai * 2 + bj) * 4 + m) * 8192), pack8(acc[ai][bj][m][0], acc[ai][bj][m][1]));
            return;
        }
        const int row0 = u.pm * BM + wr * 64 + fr, col = u.pn * 128 + wc * 32 + 8 * fq, cq = u.pn * BM + wc * 32 + 8 * fq;
        const f32x4 sg0 = *(const f32x4*)(SB + cq), sg1 = *(const f32x4*)(SB + cq + 4), su0 = *(const f32x4*)(SB + cq + HALF), su1 = *(const f32x4*)(SB + cq + HALF + 4);
        const OutBuf ob(H, (size_t)9216 * 11008 * 2); const unsigned v0 = (unsigned)(row0 * 11008 + col) * 2u;
#pragma unroll
        for (int ai = 0; ai < 2; ++ai)
#pragma unroll
            for (int m = 0; m < 4; ++m) { const float sa = SA[row0 + ai * HALF + m * 16];
                const f32x4 g0 = acc[ai][0][m][0] * (sg0 * sa), g1 = acc[ai][0][m][1] * (sg1 * sa);
                ob.st(v0, (unsigned)((ai * HALF + m * 16) * 11008) * 2u, pack8(g0 * sigm4(g0) * (acc[ai][1][m][0] * (su0 * sa)), g1 * sigm4(g1) * (acc[ai][1][m][1] * (su1 * sa)))); }
    }
};
}
constexpr int NWAVES = 8;
constexpr int DM = 4096, NBATCH = 4, SEQ = 2048, NMETA = 16, DBATCH = 128, DSEQ = 8;
constexpr int MP = NBATCH * SEQ, MSMP = DBATCH * DSEQ, M = MP + MSMP;
constexpr int SSMW = 2048, NG = 128, GS = 16, NST = 64, CONVW = 2048, DFF = 11008, INCOLS = 16384;
constexpr int NMETACOLS = 6144;
constexpr float EPS = 1e-6f;
#ifndef MK_N_LAUNCHES
#define MK_N_LAUNCHES 1
#endif
constexpr int N_PHASES = 12;
#ifndef MK_NCONV
#define MK_NCONV 0
#endif
#ifndef MK_P7_TAIL
#define MK_P7_TAIL 1
#endif
#ifndef MK_DN_CONV
#define MK_DN_CONV 11008
#endif
#ifndef MK_DN_P2
#define MK_DN_P2 11008
#endif
constexpr int DN_CONV = MK_DN_CONV, DN_P2 = MK_DN_P2;
constexpr int NCONV = MK_NCONV;
constexpr int N_LAUNCHES = MK_N_LAUNCHES;

constexpr size_t OUT_Y = 0, OUT_PRE = (size_t)M * DM, OUT_PIM = OUT_PRE + NBATCH * NG * NST, OUT_PCV = OUT_PIM + NBATCH * NG * NST,
                 OUT_SRE = OUT_PCV + NBATCH * 2 * CONVW, OUT_SIM = OUT_SRE + (size_t)DBATCH * NG * NST, OUT_SCV = OUT_SIM + (size_t)DBATCH * NG * NST,
                 OUT_END = OUT_SCV + (size_t)DBATCH * 2 * CONVW;

constexpr size_t MiB = 1u << 20;
constexpr size_t WS_CTL = 0, CTL_ZERO_BYTES = 64 * 1024;
constexpr size_t WS_LB = 1 * MiB;
constexpr size_t WS_BB = WS_LB + 256 * 1024;
constexpr size_t WS_PM = WS_BB + 1 * MiB;
constexpr size_t WS_HNM = WS_PM + 384 * 1024;
constexpr size_t WS_SMETA = WS_HNM + 128 * 1024;
constexpr size_t WS_SS1 = 3 * MiB;
constexpr size_t WS_SS2 = WS_SS1 + (size_t)M * 64 * 4;
constexpr size_t WS_WIN = 8 * MiB;
constexpr size_t WS_WGLU = WS_WIN + (size_t)INCOLS * DM * 2;
constexpr size_t WS_WCO = WS_WGLU + (size_t)2 * DM * SSMW * 2;
constexpr size_t WS_WO = WS_WCO + (size_t)DM * CONVW * 2;
constexpr size_t WS_WUP = WS_WO + (size_t)DM * DM * 2;
constexpr size_t WS_WDN = WS_WUP + (size_t)2 * DFF * DM * 2;
constexpr size_t WS_ACT = WS_WDN + (size_t)DM * DFF * 2;
constexpr size_t A36 = (size_t)M * 2048 * 2, A72 = 2 * A36;
constexpr size_t WS_R0 = WS_ACT;
constexpr size_t WS_R1 = WS_R0 + A72;
constexpr size_t WS_R2 = WS_R1 + A72;
constexpr size_t WS_R3 = WS_R2 + A36;
constexpr size_t WS_R4 = WS_R3 + A72;
constexpr size_t WS_R5 = WS_R4 + A72;
constexpr size_t WS_R6 = WS_R5 + A72;
constexpr size_t WS_END = WS_R6 + 2 * A72;
constexpr size_t WS_FR = WS_R6;
constexpr int NFRAG = 84;
constexpr size_t WS_H = WS_R1;
static_assert(WS_SS2 + (size_t)M * 64 * 4 <= WS_WIN && WS_SMETA + 64 * 1024 <= WS_SS1, "small region");
static_assert(WS_H + (size_t)M * DFF * 2 <= WS_R5, "H overlay");
static_assert(WS_END <= 1024 * MiB, "workspace budget");
constexpr int CW_BAR = 1024;
static_assert((CW_BAR + 5504) * 4 <= (int)CTL_ZERO_BYTES, "barrier words inside the memset region");

constexpr int RING_OFF = 0, RING_BYTES = 131072;
constexpr int SSM_WB = 32 * 528;
constexpr int TOT_OFF = 8 * SSM_WB;
constexpr int MISC_OFF = 147456 - 256;
static_assert(TOT_OFF + 8192 <= MISC_OFF && RING_BYTES <= MISC_OFF, "LDS map");
constexpr int LDS_BYTES = 147456;

#define GAS __attribute__((address_space(1)))
#define LAS __attribute__((address_space(3)))
typedef unsigned short bf16;
typedef unsigned v4u __attribute__((ext_vector_type(4)));
typedef unsigned v2u __attribute__((ext_vector_type(2)));
typedef float f32x4 __attribute__((ext_vector_type(4)));
typedef short bf16x8 __attribute__((ext_vector_type(8)));
#define LDS_WAIT() asm volatile("s_waitcnt lgkmcnt(0)" ::: "memory")
#define VM_WAIT() asm volatile("s_waitcnt vmcnt(0)" ::: "memory")
__device__ __forceinline__ unsigned f2bf(float f) { unsigned u = __builtin_bit_cast(unsigned, f); return (u + 0x7fffu + ((u >> 16) & 1u)) >> 16; }
__device__ __forceinline__ unsigned pk2(float lo, float hi) { return f2bf(lo) | (f2bf(hi) << 16); }
__device__ __forceinline__ float bflo(unsigned w) { return __uint_as_float(w << 16); }
__device__ __forceinline__ float bfhi(unsigned w) { return __uint_as_float(w & 0xffff0000u); }
__device__ __forceinline__ float bf1(bf16 b) { return __uint_as_float(((unsigned)b) << 16); }
#define XB_TMO      128
#define XB_XCNT(j)  (256  + 64 * (j))
#define XB_XSUB(j)  (1280 + 64 * (j))
#define XB_XGEN(j)  (2304 + 64 * (j))
#define XB_TOP      3328
#define XB_TOPGEN   3392
#define XCD_BAR_WORDS 3456
#define XB_LSUB(j)  (3456 + 64 * (j))
#define XB_LGEN(j)  (4480 + 64 * (j))
#define XCD_ALL_WORDS 5504
#define XB_SPIN_CAP (1u << 18)

__device__ __forceinline__ unsigned xb_ld(unsigned* p)              { return __hip_atomic_load(p, __ATOMIC_RELAXED, __HIP_MEMORY_SCOPE_AGENT); }
__device__ __forceinline__ unsigned xb_add(unsigned* p, unsigned v) { return __hip_atomic_fetch_add(p, v, __ATOMIC_RELAXED, __HIP_MEMORY_SCOPE_AGENT); }
__device__ __forceinline__ unsigned xb_xcc_id() { return (unsigned)__builtin_amdgcn_s_getreg((3 << 11) | 20) & 0xFu; }
#define XB_SPIN(cond, bar) do { unsigned _sp = 0; while (cond) { __builtin_amdgcn_s_sleep(1); \
    if ((++_sp & 255u) == 0u) { if (xb_ld(&(bar)[XB_TMO])) break; if (_sp > XB_SPIN_CAP) { atomicAdd(&(bar)[XB_TMO], 1u); break; } } } } while (0)

struct XcdBarrier {
    unsigned* bar; unsigned x;
    volatile LAS unsigned* st;
};

__device__ __forceinline__ XcdBarrier xcd_barrier_post(unsigned* bar, volatile LAS unsigned* st) {
    XcdBarrier b; b.bar = bar; b.x = xb_xcc_id(); b.st = st;
    if (threadIdx.x == 0) (void)xb_add(&bar[XB_XCNT(b.x)], 1u);
    return b;
}
__device__ __forceinline__ void xcd_barrier_complete(unsigned* bar, unsigned x, unsigned& nloc, unsigned& nx) {
    const unsigned G = gridDim.x * gridDim.y * gridDim.z;
    unsigned sum, cnt, mine, sp = 0u;
    for (;;) {
        sum = 0u; cnt = 0u; mine = 0u;
#pragma unroll
        for (unsigned j = 0; j < 16; ++j) { const unsigned c = xb_ld(&bar[XB_XCNT(j)]); sum += c; cnt += (c > 0u) ? 1u : 0u; mine = (j == x) ? c : mine; }
        if (sum == G) break;
        __builtin_amdgcn_s_sleep(1);
        if ((++sp & 255u) == 0u) { if (xb_ld(&bar[XB_TMO])) break; if (sp > XB_SPIN_CAP) { atomicAdd(&bar[XB_TMO], 1u); break; } }
    }
    nloc = mine > 0u ? mine : 1u; nx = cnt > 0u ? cnt : 1u;
}

__device__ __forceinline__ void xcd_barrier(const XcdBarrier& b) {
    asm volatile("s_waitcnt vmcnt(0)" ::: "memory");
    __syncthreads();
    if (threadIdx.x == 0) {
        unsigned* bar = b.bar;
        __builtin_amdgcn_s_waitcnt(0);
        unsigned nloc = b.st[0], nx = b.st[1];
        if (nloc == 0u) { xcd_barrier_complete(bar, b.x, nloc, nx); b.st[0] = nloc; b.st[1] = nx; }
        const unsigned old = xb_add(&bar[XB_XSUB(b.x)], 1u);
        const unsigned gen = old / nloc;
        if (old + 1u == (gen + 1u) * nloc) {
            __builtin_amdgcn_fence(__ATOMIC_RELEASE, "agent");
            asm volatile("s_waitcnt vmcnt(0)" ::: "memory");
            const unsigned og = xb_add(&bar[XB_TOP], 1u);
            const unsigned tg = og / nx;
            if (og + 1u == (tg + 1u) * nx) xb_add(&bar[XB_TOPGEN], 1u);
            else XB_SPIN(xb_ld(&bar[XB_TOPGEN]) == tg, bar);
            __builtin_amdgcn_fence(__ATOMIC_ACQUIRE, "agent");
            xb_add(&bar[XB_XGEN(b.x)], 1u);
            asm volatile("s_waitcnt vmcnt(0)" ::: "memory");
        } else {
            XB_SPIN(xb_ld(&bar[XB_XGEN(b.x)]) == gen, bar);
            __builtin_amdgcn_fence(__ATOMIC_ACQUIRE, "agent");
            asm volatile("s_waitcnt vmcnt(0)" ::: "memory");
        }
    }
    __syncthreads();
}
__device__ __forceinline__ void xcd_local_sync(const XcdBarrier& b) {
    asm volatile("" ::: "memory"); __builtin_amdgcn_s_barrier(); asm volatile("" ::: "memory");
    if (threadIdx.x == 0) {
        unsigned* bar = b.bar; unsigned nloc = b.st[0], nx = b.st[1];
        if (nloc == 0u) { xcd_barrier_complete(bar, b.x, nloc, nx); b.st[0] = nloc; b.st[1] = nx; }
        const unsigned old = xb_add(&bar[XB_LSUB(b.x)], 1u), gen = old / nloc;
        if (old + 1u == (gen + 1u) * nloc) xb_add(&bar[XB_LGEN(b.x)], 1u);
        else XB_SPIN(xb_ld(&bar[XB_LGEN(b.x)]) == gen, bar);
    }
    asm volatile("" ::: "memory"); __builtin_amdgcn_s_barrier(); asm volatile("" ::: "memory");
}
struct XcdSyncHook { XcdBarrier b; __device__ __forceinline__ void operator()() const { xcd_local_sync(b); } };
__device__ __forceinline__ float wave_sum(float v) {
#pragma unroll
    for (int o = 1; o < 64; o <<= 1) v += __shfl_xor(v, o);
    return v;
}
__device__ __forceinline__ float gelu_tanh(float x) {
    const float y = 0.7978845608028654f * (x + 0.044715f * x * x * x);
    const float e = __builtin_amdgcn_exp2f(2.885390081777927f * y);
    const float th = 1.0f - 2.0f * __builtin_amdgcn_rcpf(e + 1.0f);
    return 0.5f * x * (1.0f + th);
}
#ifndef MK_NT_COPY
#define MK_NT_COPY 1
#endif
#ifndef MK_WDROP
#define MK_WDROP 0
#endif
__device__ __forceinline__ unsigned f2bfw(float f) { unsigned u = __builtin_bit_cast(unsigned, f); const int sh = 16 + MK_WDROP; return ((u + ((1u << (sh - 1)) - 1u) + ((u >> sh) & 1u)) >> sh) << MK_WDROP; }
__device__ __forceinline__ unsigned pk2w(float lo, float hi) { return MK_WDROP ? (f2bfw(lo) | (f2bfw(hi) << 16)) : pk2(lo, hi); }
template <bool NT = false> __device__ __forceinline__ void p0_transpose_item(const float* W, int Nsrc, int c0, bf16* WT, int K, int r0, int k0, LAS unsigned* scr, int lane) {
    const float* src = W + (size_t)k0 * Nsrc + c0 + lane;
    float v[64];
#pragma unroll
    for (int i = 0; i < 64; ++i) v[i] = __builtin_nontemporal_load(src + (size_t)i * Nsrc);
#pragma unroll
    for (int i = 0; i < 32; ++i) scr[i * 66 + lane] = pk2w(v[2 * i], v[2 * i + 1]);
    LDS_WAIT(); asm volatile("" ::: "memory");
    const int c = lane & 7;
#pragma unroll
    for (int j = 0; j < 8; ++j) { const int n = (lane >> 3) + 8 * j; const LAS unsigned* s = scr + (4 * c) * 66 + n;
        v4u o; o.x = s[0]; o.y = s[66]; o.z = s[132]; o.w = s[198];
        GAS v4u* d = (GAS v4u*)(WT + (size_t)(r0 + n) * K + k0 + 8 * c); if (NT) __builtin_nontemporal_store(o, d); else *d = o; }
    LDS_WAIT(); asm volatile("" ::: "memory");
}
__device__ __forceinline__ unsigned q8pack(f32x4 v) {
    unsigned w = 0u;
    w = __builtin_amdgcn_cvt_pk_u8_f32(__builtin_rintf(v.x + 128.0f), 0, w); w = __builtin_amdgcn_cvt_pk_u8_f32(__builtin_rintf(v.y + 128.0f), 1, w);
    w = __builtin_amdgcn_cvt_pk_u8_f32(__builtin_rintf(v.z + 128.0f), 2, w); w = __builtin_amdgcn_cvt_pk_u8_f32(__builtin_rintf(v.w + 128.0f), 3, w);
    return w ^ 0x80808080u;
}
__device__ __forceinline__ void rms_row_to_bf16(const float* xrow, const float* g, bf16* orow, signed char* q8row, float* q8scale, int lane) {
    const GAS f32x4* xr = (const GAS f32x4*)xrow + lane; const GAS f32x4* gr = (const GAS f32x4*)g + lane;
    f32x4 v[16]; float s = 0.f;
#pragma unroll
    for (int j = 0; j < 16; ++j) { v[j] = xr[64 * j]; s += (v[j].x * v[j].x + v[j].y * v[j].y) + (v[j].z * v[j].z + v[j].w * v[j].w); }
    const float rstd = 1.0f / sqrtf(wave_sum(s) * (1.0f / DM) + EPS);
    GAS v2u* o8 = (GAS v2u*)orow + lane; float amax = 0.f;
#pragma unroll
    for (int j = 0; j < 16; ++j) { const f32x4 gv = gr[64 * j]; v[j] = v[j] * rstd * gv; v2u o; o.x = pk2(v[j].x, v[j].y); o.y = pk2(v[j].z, v[j].w); o8[64 * j] = o;
        amax = fmaxf(amax, fmaxf(fmaxf(fabsf(v[j].x), fabsf(v[j].y)), fmaxf(fabsf(v[j].z), fabsf(v[j].w)))); }
    if (q8row) {
#pragma unroll
        for (int o = 1; o < 64; o <<= 1) amax = fmaxf(amax, __shfl_xor(amax, o));
        const float qs = amax > 0.f ? 127.0f / amax : 0.f;
        if (lane == 0) *q8scale = amax * (1.0f / 127.0f);
        GAS unsigned* q4 = (GAS unsigned*)q8row + lane;
#pragma unroll
        for (int j = 0; j < 16; ++j) q4[64 * j] = q8pack(v[j] * qs);
    }
}

__device__ __forceinline__ void q8_strip(const float* W, int Nsrc, int c0, signed char* WT8, float* SB, int r0, LAS unsigned char* lds, int wave, int lane) {
    LAS float* red = (LAS float*)(lds + 12288); LAS unsigned* scr = (LAS unsigned*)(lds + wave * 16384);
    const float* src = W + (size_t)(wave * 512) * Nsrc + c0 + lane;
    float amax = 0.f;
    for (int t = 0; t < 8; ++t) { float v[64];
#pragma unroll
        for (int i = 0; i < 64; ++i) v[i] = src[(size_t)(t * 64 + i) * Nsrc];
#pragma unroll
        for (int i = 0; i < 64; ++i) amax = fmaxf(amax, fabsf(v[i])); }
    red[wave * 64 + lane] = amax;
    __syncthreads();
    float cmax = 0.f;
#pragma unroll
    for (int w = 0; w < 8; ++w) cmax = fmaxf(cmax, red[w * 64 + lane]);
    const float qs = cmax > 0.f ? 127.0f / cmax : 0.f;
    if (wave == 0) SB[r0 + lane] = cmax * (1.0f / 127.0f);
    for (int t = 0; t < 8; ++t) { float v[64];
#pragma unroll
        for (int i = 0; i < 64; ++i) v[i] = src[(size_t)(t * 64 + i) * Nsrc];
#pragma unroll
        for (int i = 0; i < 16; ++i) scr[i * 66 + lane] = q8pack((f32x4){v[4 * i] * qs, v[4 * i + 1] * qs, v[4 * i + 2] * qs, v[4 * i + 3] * qs});
        LDS_WAIT(); asm volatile("" ::: "memory");
        const int c = lane & 3;
#pragma unroll
        for (int jj = 0; jj < 4; ++jj) { const int n = (lane >> 2) + 16 * jj; const LAS unsigned* sq = scr + (4 * c) * 66 + n;
            v4u o; o.x = sq[0]; o.y = sq[66]; o.z = sq[132]; o.w = sq[198];
            *(GAS v4u*)(WT8 + (size_t)(r0 + n) * 4096 + wave * 512 + t * 64 + 16 * c) = o; }
        LDS_WAIT(); asm volatile("" ::: "memory"); }
    __syncthreads();
}
#define TR_LOAD(v, t) do { _Pragma("unroll") for (int i = 0; i < 16; ++i) v[i] = __builtin_nontemporal_load(src + (size_t)((t) * 64 + i) * (size_t)(Nsrc >> 2)); __builtin_amdgcn_sched_barrier(0); } while (0)
#define TR_EMIT_BF(v, t) do { _Pragma("unroll") for (int e = 0; e < 4; ++e) { v4u o0, o1; \
        o0.x = pk2w(v[0][e], v[1][e]); o0.y = pk2w(v[2][e], v[3][e]); o0.z = pk2w(v[4][e], v[5][e]); o0.w = pk2w(v[6][e], v[7][e]); \
        o1.x = pk2w(v[8][e], v[9][e]); o1.y = pk2w(v[10][e], v[11][e]); o1.z = pk2w(v[12][e], v[13][e]); o1.w = pk2w(v[14][e], v[15][e]); \
        GAS v4u* d = (GAS v4u*)(dst + (size_t)e * K + (t) * 64); __builtin_nontemporal_store(o0, d); __builtin_nontemporal_store(o1, d + 1); } } while (0)
#define TR_EMIT_I8(v, t) do { _Pragma("unroll") for (int e = 0; e < 4; ++e) { const float sc = qv[e]; v4u o; \
        o.x = q8pack((f32x4){v[0][e] * sc, v[1][e] * sc, v[2][e] * sc, v[3][e] * sc}); o.y = q8pack((f32x4){v[4][e] * sc, v[5][e] * sc, v[6][e] * sc, v[7][e] * sc}); \
        o.z = q8pack((f32x4){v[8][e] * sc, v[9][e] * sc, v[10][e] * sc, v[11][e] * sc}); o.w = q8pack((f32x4){v[12][e] * sc, v[13][e] * sc, v[14][e] * sc, v[15][e] * sc}); \
        { GAS v4u* d_ = (GAS v4u*)(dst + (size_t)e * 4096 + (t) * 64); if (MK_NT_COPY) __builtin_nontemporal_store(o, d_); else *d_ = o; } } } while (0)
#define TR_PIPE(EMIT) do { f32x4 va[16], vb[16]; TR_LOAD(va, 0); \
        _Pragma("unroll") for (int t = 0; t < NT; t += 2) { if (t + 1 < NT) TR_LOAD(vb, t + 1); EMIT(va, t); if (t + 1 < NT) { if (t + 2 < NT) TR_LOAD(va, t + 2); EMIT(vb, t + 1); } } } while (0)
#define TR_PIPE3(EMIT) do { f32x4 va[16], vb[16], vc[16]; TR_LOAD(va, 0); if (1 < NT) TR_LOAD(vb, 1); \
        _Pragma("unroll") for (int t = 0; t < NT; t += 3) { if (t + 2 < NT) TR_LOAD(vc, t + 2); EMIT(va, t); \
            if (t + 1 < NT) { if (t + 3 < NT) TR_LOAD(va, t + 3); EMIT(vb, t + 1); } \
            if (t + 2 < NT) { if (t + 4 < NT) TR_LOAD(vb, t + 4); EMIT(vc, t + 2); } } } while (0)
template <int NT> __device__ __forceinline__ void tr_run(const float* W, int Nsrc, int c0, bf16* WT, int K, int r0, int k0, int lane) {
    const int q = lane & 15, h = lane >> 4;
    const GAS f32x4* src = (const GAS f32x4*)(W + (size_t)(k0 + 16 * h) * Nsrc + c0 + 4 * q);
    bf16* dst = WT + (size_t)(r0 + 4 * q) * K + k0 + 16 * h;
    TR_PIPE(TR_EMIT_BF);
}
template <int NT> __device__ __forceinline__ void q8_run(const float* W, int Nsrc, int c0, signed char* WT8, int r0, int k0, float qs, int lane) {
    const int q = lane & 15, h = lane >> 4;
    f32x4 qv; qv.x = __shfl(qs, 4 * q); qv.y = __shfl(qs, 4 * q + 1); qv.z = __shfl(qs, 4 * q + 2); qv.w = __shfl(qs, 4 * q + 3);
    const GAS f32x4* src = (const GAS f32x4*)(W + (size_t)(k0 + 16 * h) * Nsrc + c0 + 4 * q);
    signed char* dst = WT8 + (size_t)(r0 + 4 * q) * 4096 + k0 + 16 * h;
    TR_PIPE3(TR_EMIT_I8);
}
struct Args { const float* in[27]; float* out; unsigned char* ws; int ph_lo, ph_hi; };
__device__ __forceinline__ const float* in_ptr(int i) {
    const __attribute__((address_space(4))) char* ka = (const __attribute__((address_space(4))) char*)__builtin_amdgcn_kernarg_segment_ptr();
    asm volatile("" : "+s"(ka));
    return *(const float* const __attribute__((address_space(4)))*)(ka + 8 * i);
}

typedef float f32x16 __attribute__((ext_vector_type(16)));
__device__ __forceinline__ int ssm_off(int j, int q) { return j * 528 + q * 4; }
template <bool PROMPT>
__device__ __forceinline__ void ssm_tile(LAS unsigned char* wb, LAS float* tot, const bf16* U, bf16* YS, const unsigned char* FRg, const float* LB, const float* SMETA,
                                         const float* st_re, const float* st_im, float* out, int g, int bq, int rowbase, int wave, int lane) {
    const int j = lane & 31, h2 = lane >> 5;
    const __amdgpu_buffer_rsrc_t rsF = __builtin_amdgcn_make_buffer_rsrc((void*)FRg, (short)0, NFRAG * 1024, 0x00020000);
    const __amdgpu_buffer_rsrc_t rsU = __builtin_amdgcn_make_buffer_rsrc((void*)(U + (size_t)rowbase * SSMW + g * 16), (short)0, 256 * SSMW * 2, 0x00020000);
    const unsigned voffF = (unsigned)lane * 16u, voffU = (unsigned)(8 * j * SSMW + 8 * h2) * 2u;
#define SSM_LDF(f) __builtin_bit_cast(bf16x8, __builtin_amdgcn_raw_buffer_load_b128(rsF, voffF, (f) * 1024, 0))
    bf16x8 X[8], WA[16], WB[16];
#pragma unroll
    for (int ks = 0; ks < 8; ++ks) X[ks] = __builtin_bit_cast(bf16x8, __builtin_amdgcn_raw_buffer_load_b128(rsU, voffU, ks * SSMW * 2, 0));
#pragma unroll
    for (int f = 0; f < 16; ++f) WA[f] = SSM_LDF(f);
    __builtin_amdgcn_sched_barrier(0);
#pragma unroll
    for (int f = 0; f < 16; ++f) WB[f] = SSM_LDF(16 + f);
    __builtin_amdgcn_sched_barrier(0);
#pragma unroll
    for (int qb = 0; qb < 4; ++qb) { f32x16 acc = {};
#pragma unroll
        for (int ks = 0; ks < 8; ++ks) acc = __builtin_amdgcn_mfma_f32_32x32x16_bf16(qb < 2 ? WA[qb * 8 + ks] : WB[(qb - 2) * 8 + ks], X[ks], acc, 0, 0, 0);
#pragma unroll
        for (int c4 = 0; c4 < 4; ++c4) *(LAS f32x4*)(wb + ssm_off(j, 32 * qb + 8 * c4 + 4 * h2)) = (f32x4){acc[4 * c4], acc[4 * c4 + 1], acc[4 * c4 + 2], acc[4 * c4 + 3]};
        __builtin_amdgcn_sched_barrier(0); }
    bf16x8 A0[10];
#pragma unroll
    for (int f = 0; f < 2; ++f) A0[f] = SSM_LDF(32 + f);
#pragma unroll
    for (int f = 0; f < 8; ++f) A0[2 + f] = SSM_LDF(52 + f);
    __builtin_amdgcn_sched_barrier(0);
    LDS_WAIT();
    const int gp = g * 64 + lane;
    float fre[32], fim[32];
#pragma unroll
    for (int jj = 0; jj < 32; ++jj) { fre[jj] = *(LAS float*)(wb + ssm_off(jj, lane)); fim[jj] = *(LAS float*)(wb + ssm_off(jj, 64 + lane)); }
    const float a1r = LB[2 * 8192 + gp], a1i = LB[3 * 8192 + gp];
    if (PROMPT) {
        const float a32r = LB[4 * 8192 + gp], a32i = LB[5 * 8192 + gp];
        float sr = SMETA[gp], si = SMETA[8192 + gp];
        float tr = 0.f, ti = 0.f;
#pragma unroll
        for (int jj = 0; jj < 32; ++jj) { const float nr = a1r * tr - a1i * ti + fre[jj], ni = a1r * ti + a1i * tr + fim[jj]; tr = nr; ti = ni; }
        tot[wave * 128 + lane] = tr; tot[wave * 128 + 64 + lane] = ti;
        __syncthreads();
        for (int w2 = 0; w2 < wave; ++w2) { const float xr = tot[w2 * 128 + lane], xi = tot[w2 * 128 + 64 + lane]; const float nr = a32r * sr - a32i * si + xr, ni = a32r * si + a32i * sr + xi; sr = nr; si = ni; }
        if (wave == 7) { out[OUT_PRE + (size_t)(bq * NG + g) * NST + lane] = a32r * sr - a32i * si + tr; out[OUT_PIM + (size_t)(bq * NG + g) * NST + lane] = a32r * si + a32i * sr + ti; }
#pragma unroll
        for (int jj = 0; jj < 32; ++jj) { *(LAS float*)(wb + ssm_off(jj, lane)) = sr; *(LAS float*)(wb + ssm_off(jj, 64 + lane)) = si;
            const float nr = a1r * sr - a1i * si + fre[jj], ni = a1r * si + a1i * sr + fim[jj]; sr = nr; si = ni; }
    } else {
#pragma unroll
        for (int j0 = 0; j0 < 32; j0 += 8) { float s0r[8], s0i[8];
#pragma unroll
            for (int jj = 0; jj < 8; ++jj) { const size_t so = ((size_t)(bq + j0 + jj) * NG + g) * NST + lane; s0r[jj] = st_re[so]; s0i[jj] = st_im[so]; }
            __builtin_amdgcn_sched_barrier(0);
#pragma unroll
            for (int jj = 0; jj < 8; ++jj) { const size_t so = ((size_t)(bq + j0 + jj) * NG + g) * NST + lane; const float sr = s0r[jj], si = s0i[jj];
                *(LAS float*)(wb + ssm_off(j0 + jj, lane)) = sr; *(LAS float*)(wb + ssm_off(j0 + jj, 64 + lane)) = si;
                out[OUT_SRE + so] = a1r * sr - a1i * si + fre[j0 + jj]; out[OUT_SIM + so] = a1r * si + a1i * sr + fim[j0 + jj]; } }
    }
    LDS_WAIT();
    bf16x8 S[8];
#pragma unroll
    for (int ks = 0; ks < 8; ++ks) { const f32x4 v0 = *(LAS f32x4*)(wb + ssm_off(j, 16 * ks + 8 * h2)), v1 = *(LAS f32x4*)(wb + ssm_off(j, 16 * ks + 8 * h2 + 4));
        S[ks] = __builtin_bit_cast(bf16x8, pg8::pack8(v0, v1)); }
#define SSM_OUT(rb, acc) do { _Pragma("unroll") for (int c4 = 0; c4 < 4; ++c4) { const int t = 2 * (rb) + (c4 >> 1), h0 = 8 * (c4 & 1) + 4 * h2; \
        v2u o; o.x = pg8::cvt_pk_bf16(gelu_tanh(acc[4 * c4]), gelu_tanh(acc[4 * c4 + 1])); o.y = pg8::cvt_pk_bf16(gelu_tanh(acc[4 * c4 + 2]), gelu_tanh(acc[4 * c4 + 3])); \
        *(GAS v2u*)(YS + (size_t)(rowbase + 8 * j + t) * SSMW + g * 16 + h0) = o; } } while (0)
    __builtin_amdgcn_sched_barrier(0);
    { bf16x8 A1[12];
#pragma unroll
      for (int f = 0; f < 4; ++f) A1[f] = SSM_LDF(34 + f);
#pragma unroll
      for (int f = 0; f < 8; ++f) A1[4 + f] = SSM_LDF(60 + f);
      __builtin_amdgcn_sched_barrier(0);
      f32x16 acc = {};
#pragma unroll
      for (int ks = 0; ks < 2; ++ks) acc = __builtin_amdgcn_mfma_f32_32x32x16_bf16(A0[ks], X[ks], acc, 0, 0, 0);
#pragma unroll
      for (int ks = 0; ks < 8; ++ks) acc = __builtin_amdgcn_mfma_f32_32x32x16_bf16(A0[2 + ks], S[ks], acc, 0, 0, 0);
      __builtin_amdgcn_sched_barrier(0);
      bf16x8 A2[14];
#pragma unroll
      for (int f = 0; f < 6; ++f) A2[f] = SSM_LDF(38 + f);
#pragma unroll
      for (int f = 0; f < 8; ++f) A2[6 + f] = SSM_LDF(68 + f);
      __builtin_amdgcn_sched_barrier(0);
      SSM_OUT(0, acc);
      __builtin_amdgcn_sched_barrier(0);
      f32x16 acc1 = {};
#pragma unroll
      for (int ks = 0; ks < 4; ++ks) acc1 = __builtin_amdgcn_mfma_f32_32x32x16_bf16(A1[ks], X[ks], acc1, 0, 0, 0);
#pragma unroll
      for (int ks = 0; ks < 8; ++ks) acc1 = __builtin_amdgcn_mfma_f32_32x32x16_bf16(A1[4 + ks], S[ks], acc1, 0, 0, 0);
      __builtin_amdgcn_sched_barrier(0);
      bf16x8 A3[16];
#pragma unroll
      for (int f = 0; f < 8; ++f) A3[f] = SSM_LDF(44 + f);
#pragma unroll
      for (int f = 0; f < 8; ++f) A3[8 + f] = SSM_LDF(76 + f);
      __builtin_amdgcn_sched_barrier(0);
      SSM_OUT(1, acc1);
      __builtin_amdgcn_sched_barrier(0);
      f32x16 acc2 = {};
#pragma unroll
      for (int ks = 0; ks < 6; ++ks) acc2 = __builtin_amdgcn_mfma_f32_32x32x16_bf16(A2[ks], X[ks], acc2, 0, 0, 0);
#pragma unroll
      for (int ks = 0; ks < 8; ++ks) acc2 = __builtin_amdgcn_mfma_f32_32x32x16_bf16(A2[6 + ks], S[ks], acc2, 0, 0, 0);
      SSM_OUT(2, acc2);
      __builtin_amdgcn_sched_barrier(0);
      f32x16 acc3 = {};
#pragma unroll
      for (int ks = 0; ks < 8; ++ks) acc3 = __builtin_amdgcn_mfma_f32_32x32x16_bf16(A3[ks], X[ks], acc3, 0, 0, 0);
#pragma unroll
      for (int ks = 0; ks < 8; ++ks) acc3 = __builtin_amdgcn_mfma_f32_32x32x16_bf16(A3[8 + ks], S[ks], acc3, 0, 0, 0);
      SSM_OUT(3, acc3); }
#undef SSM_OUT
#undef SSM_LDF
}

__global__ void __launch_bounds__(NWAVES * 64, 2) fwd(Args args) {
    extern __shared__ __attribute__((aligned(16))) unsigned char lds_raw[];
    LAS unsigned char* lds = (LAS unsigned char*)lds_raw;
    volatile LAS unsigned* MISC = (volatile LAS unsigned*)(lds + MISC_OFF);
    const int tid = threadIdx.x, lane = tid & 63, wave = __builtin_amdgcn_readfirstlane(tid >> 6);
    const int G = gridDim.x; const int bx = blockIdx.x; const int vcu = (G % 8 == 0) ? (bx % 8) * (G / 8) + bx / 8 : bx;
    const int gw = vcu * NWAVES + wave, NGW = G * NWAVES;
    unsigned char* ws = args.ws;
    unsigned* ctl = (unsigned*)(ws + WS_CTL);
    float* out = args.out;
    float* LB = (float*)(ws + WS_LB); float* BB = (float*)(ws + WS_BB); float* PM = (float*)(ws + WS_PM); bf16* HNM = (bf16*)(ws + WS_HNM);
    float* SMETA = (float*)(ws + WS_SMETA);
    bf16* WT_IN = (bf16*)(ws + WS_WIN); bf16* WT_GLU = (bf16*)(ws + WS_WGLU); bf16* WT_CO = (bf16*)(ws + WS_WCO); bf16* WT_O = (bf16*)(ws + WS_WO); bf16* WT_UP = (bf16*)(ws + WS_WUP); bf16* WT_DN = (bf16*)(ws + WS_WDN);
    bf16* HN = (bf16*)(ws + WS_R0); bf16* YS = (bf16*)(ws + WS_R0); bf16* YC = (bf16*)(ws + WS_R0 + A36); bf16* HF = (bf16*)(ws + WS_R0);
    bf16* U = (bf16*)(ws + WS_R1); bf16* Z = (bf16*)(ws + WS_R1 + A36); bf16* M1 = (bf16*)(ws + WS_R6 + A72);
    bf16* CB = (bf16*)(ws + WS_R2); bf16* SGA = (bf16*)(ws + WS_R3); bf16* SGB = (bf16*)(ws + WS_R4); bf16* MG = (bf16*)(ws + WS_R5);
    signed char* HN8 = (signed char*)(ws + WS_R5); signed char* WT_IN8 = (signed char*)(ws + WS_WIN + (size_t)64 * MiB); float* SAH = (float*)(ws + WS_SS1 + 131072); float* SBIN = (float*)(ws + WS_SS2 + 131072); signed char* HF8 = (signed char*)(ws + WS_R0); signed char* WT_UP8 = (signed char*)(ws + WS_WUP); float* SA = (float*)(ws + WS_SS1 + 65536); float* SB = (float*)(ws + WS_SS2); float* AMX = (float*)(ws + WS_R6 + A72);       bf16* OB = (bf16*)(ws + WS_R6); bf16* FB = (bf16*)(ws + WS_R6 + A72); bf16* XT = (bf16*)(ws + WS_WIN);   float* RS1 = (float*)(ws + WS_SS1); bf16* HB = (bf16*)(ws + WS_H);

    for (int u = tid; u < 64; u += NWAVES * 64) MISC[u] = 0u;
    __syncthreads();
    XcdBarrier bar; bar.bar = ctl + CW_BAR; bar.x = 0; bar.st = nullptr;
    if (N_LAUNCHES != N_PHASES) bar = xcd_barrier_post(ctl + CW_BAR, MISC + 8);
#define GRID_BAR() do { if (N_LAUNCHES != N_PHASES) xcd_barrier(bar); } while (0)
    const int lo = args.ph_lo, hi = args.ph_hi;
#define IN(k) (lo <= (k) && (k) < hi)
#define BOTH(k) (IN(k) && IN((k) + 1))

    if (IN(0)) {
        const float* x_prompt = in_ptr(0); const float* x_sample = in_ptr(1); const float* meta = in_ptr(5); const float* g_pre_mix = in_ptr(6); const float* w_in = in_ptr(7);
        const float* lam_re = in_ptr(8); const float* lam_im = in_ptr(9); const float* log_dt = in_ptr(10); const float* b_re = in_ptr(11); const float* b_im = in_ptr(12);
        const float* c_re = in_ptr(13); const float* c_im = in_ptr(14); const float* ssm_d = in_ptr(15); const float* w_glu_v = in_ptr(16); const float* w_glu_g = in_ptr(17);
        const float* w_conv_out = in_ptr(19); const float* w_o = in_ptr(20); const float* w_ffn_gate = in_ptr(23); const float* w_ffn_up = in_ptr(24); const float* w_ffn_down = in_ptr(25);
        for (int g = bx; g < NG; g += G) {
            LAS float* LPR = (LAS float*)(lds + RING_OFF); LAS float* LPI = LPR + 9 * 64; LAS float* BR = LPI + 9 * 64; LAS float* BI = BR + 1024;
            LAS float* CR = BI + 1024; LAS float* CI = CR + 1024; LAS float* MT = CI + 1024; LAS float* DD = MT + 2048;
            { const double dt = exp((double)log_dt[g]);
              for (int e = tid; e < 10 * 64; e += NWAVES * 64) {
                const int p = e & 63, dsel = e >> 6, idx = g * 64 + p; const double dd = dsel < 9 ? (double)dsel : 256.0;
                const double a = (double)lam_re[idx] * dt * dd, b = (double)lam_im[idx] * dt * dd, ea = exp(a); const float vr = (float)(ea * cos(b)), vi = (float)(ea * sin(b));
                if (dsel < 9) { LPR[dsel * 64 + p] = vr; LPI[dsel * 64 + p] = vi; }
                if (dsel == 1) { LB[idx] = vr; LB[8192 + idx] = vi; } else if (dsel == 8) { LB[2 * 8192 + idx] = vr; LB[3 * 8192 + idx] = vi; } else if (dsel == 9) { LB[4 * 8192 + idx] = vr; LB[5 * 8192 + idx] = vi; } }
              if (tid >= 128 && tid < 192) {
                const int p = tid - 128, idx = g * 64 + p; const double lr = (double)lam_re[idx], li = (double)lam_im[idx];
                const double a = lr * dt, b = li * dt, ea = exp(a), sb = sin(b), cb = cos(b);
                const double sh = sin(0.5 * b), nr = expm1(a) * cb - 2.0 * sh * sh, ni = ea * sb;
                const double inv = 1.0 / (lr * lr + li * li), qr = (nr * lr + ni * li) * inv, qi = (ni * lr - nr * li) * inv;
                for (int h = 0; h < 16; ++h) { const double br = (double)b_re[idx * 16 + h], bi = (double)b_im[idx * 16 + h];
                    const float vr = (float)(qr * br - qi * bi), vi = (float)(qr * bi + qi * br);
                    BB[idx * 16 + h] = vr; BB[131072 + idx * 16 + h] = vi; BR[p * 16 + h] = vr; BI[p * 16 + h] = vi; } } }
            for (int i = tid; i < 1024; i += NWAVES * 64) { CR[i] = c_re[g * 1024 + i]; CI[i] = c_im[g * 1024 + i]; }
            if (tid < 16) DD[tid] = ssm_d[g * 16 + tid];
            __syncthreads();
            for (int e = tid; e < 2048; e += NWAVES * 64) { const int d = e >> 8, h = (e >> 4) & 15, hp = e & 15; float sacc = 0.f;
                for (int p = 0; p < 64; ++p) { const float cr = CR[h * 64 + p], ci = CI[h * 64 + p], lr = LPR[d * 64 + p], li = LPI[d * 64 + p];
                    const float tr = cr * lr - ci * li, ti = cr * li + ci * lr; sacc += tr * BR[p * 16 + hp] - ti * BI[p * 16 + hp]; }
                MT[e] = sacc; }
            __syncthreads();
            unsigned char* FRg = ws + WS_FR + (size_t)g * NFRAG * 1024;
            for (int pr = tid; pr < NFRAG * 64; pr += NWAVES * 64) {
                const int f = pr >> 6, l = pr & 63, row = l & 31, kb = 8 * (l >> 5); float v[8];
                if (f < 32) { const int qb = f >> 3, ks = f & 7, q = 32 * qb + row, p = q & 63;
#pragma unroll
                    for (int i = 0; i < 8; ++i) { const float lr = LPR[(7 - ks) * 64 + p], li = LPI[(7 - ks) * 64 + p], br = BR[p * 16 + kb + i], bi = BI[p * 16 + kb + i];
                        v[i] = (q < 64) ? (lr * br - li * bi) : (lr * bi + li * br); }
                } else if (f < 52) { const int ft = f - 32, rb = ft < 2 ? 0 : (ft < 6 ? 1 : (ft < 12 ? 2 : 3)), ks = ft - rb * (rb + 1), t = 2 * rb + (row >> 4), h = row & 15;
#pragma unroll
                    for (int i = 0; i < 8; ++i) { const int hp = kb + i; float x = 0.f; if (t >= ks) { x = MT[((t - ks) << 8) + (h << 4) + hp]; if (t == ks && h == hp) x += DD[h]; } v[i] = x; }
                } else { const int fg = f - 52, rb = fg >> 3, ks = fg & 7, t = 2 * rb + (row >> 4), h = row & 15;
#pragma unroll
                    for (int i = 0; i < 8; ++i) { const int q = 16 * ks + kb + i, p = q & 63; const float cr = CR[h * 64 + p], ci = CI[h * 64 + p], lr = LPR[(t + 1) * 64 + p], li = LPI[(t + 1) * 64 + p];
                        v[i] = (q < 64) ? (cr * lr - ci * li) : -(cr * li + ci * lr); }
                }
                v4u o; o.x = pk2(v[0], v[1]); o.y = pk2(v[2], v[3]); o.z = pk2(v[4], v[5]); o.w = pk2(v[6], v[7]);
                *(GAS v4u*)(FRg + (size_t)pr * 16) = o;
            }
            __syncthreads();
        }
        LAS unsigned* scr = (LAS unsigned*)(lds + RING_OFF + wave * 16384);
        if (bx >= G - NG) { const int st = bx - (G - NG);
            q8_strip(w_in, INCOLS, 8192 + 64 * st, WT_IN8, SBIN, 64 * st, lds + RING_OFF, wave, lane); }
        constexpr int I_IN = (DM / 64) * (8192 / 64);
        for (int it = gw; it < I_IN; it += NGW) {
            const int nblk = 8192 / 64, kb = it / nblk, nb = it % nblk, r0 = nb * 64; int c0;
            if (r0 < 2048) c0 = r0;
            else if (r0 < 6144) { const int q = r0 - 2048; c0 = (((q >> 7) & 1) ? 6144 : 2048) + 128 * (q >> 8) + (q & 127); }
            else if (r0 < 8192) c0 = 4096 + (r0 - 6144);
            else c0 = r0;
            p0_transpose_item(w_in, INCOLS, c0, WT_IN, DM, r0, kb * 64, scr, lane);
        }
        for (int it = gw; it < 2 * (DFF / 256) * (DM / 64); it += NGW) {
            const int kc = it / (2 * (DFF / 256)), sp = it % (2 * (DFF / 256)), sel = sp / (DFF / 256), c0 = (sp % (DFF / 256)) * 256 + 4 * lane;
            const GAS f32x4* src = (const GAS f32x4*)((sel ? w_ffn_up : w_ffn_gate) + (size_t)(kc * 64) * DFF + c0);
            f32x4 mx = (f32x4){0.f, 0.f, 0.f, 0.f};
#pragma unroll
            for (int t = 0; t < 4; ++t) { f32x4 v[16];
#pragma unroll
                for (int i = 0; i < 16; ++i) v[i] = __builtin_nontemporal_load(src + (size_t)(t * 16 + i) * (DFF / 4));
#pragma unroll
                for (int i = 0; i < 16; ++i) { mx.x = fmaxf(mx.x, fabsf(v[i].x)); mx.y = fmaxf(mx.y, fabsf(v[i].y)); mx.z = fmaxf(mx.z, fabsf(v[i].z)); mx.w = fmaxf(mx.w, fabsf(v[i].w)); } }
            *(GAS f32x4*)(AMX + (size_t)kc * (2 * DFF) + 256 * (c0 >> 7) + 128 * sel + (c0 & 127)) = mx; }
        for (int m = gw; m < M + NMETA; m += NGW) {
            const float* xr = m < MP ? x_prompt + (size_t)m * DM : (m < M ? x_sample + (size_t)(m - MP) * DM : meta + (size_t)(m - M) * DM);
            bf16* orow = m < M ? HN + (size_t)m * DM : HNM + (size_t)(m - M) * DM;
            rms_row_to_bf16(xr, g_pre_mix, orow, m < M ? HN8 + (size_t)m * DM : nullptr, SAH + (m < M ? m : 0), lane);
        }
        if (BOTH(0)) GRID_BAR();
    }

    if (IN(1)) {
      const int GG = G - NCONV;
      if (NCONV == 0 || bx >= GG) {
        const int cw0 = NCONV ? (bx - GG) * NWAVES + wave : gw, cwn = NCONV ? NCONV * NWAVES : NGW;
        const float* w_glu_v = in_ptr(16); const float* w_glu_g = in_ptr(17); const float* w_conv_out = in_ptr(19); const float* w_o = in_ptr(20);
        const float* w_ffn_gate = in_ptr(23); const float* w_ffn_up = in_ptr(24); const float* w_ffn_down = in_ptr(25);
#ifdef MK_PROBE_C2
        for (int rep = 0; rep < 2; ++rep) {
#endif
        constexpr int I_UP = (2 * DFF / 64) * (DM / 256), I_GLU = (SSMW / 256) * (2 * DM / 64), I_CO = (CONVW / 256) * (DM / 64), I_O = (DM / 256) * (DM / 64);
        constexpr int NITEMS = I_UP + I_GLU + I_CO + I_O + DN_CONV;
        for (int it = cw0; it < NITEMS; it += cwn) {
            int r = it;
            if (r < I_UP) { const int ch = r / (2 * DFF / 64), st = r % (2 * DFF / 64), r0 = st * 64; float cmax = 0.f;
#pragma unroll
                for (int c = 0; c < DM / 64; ++c) cmax = fmaxf(cmax, AMX[c * (2 * DFF) + r0 + lane]);
                if (ch == 0) SB[r0 + lane] = cmax * (1.0f / 127.0f);
                q8_run<4>(((r0 >> 7) & 1) ? w_ffn_up : w_ffn_gate, DFF, 128 * (r0 >> 8) + (r0 & 127), WT_UP8, r0, ch * 256, cmax > 0.f ? 127.0f / cmax : 0.f, lane); continue; } r -= I_UP;
            if (r < I_GLU) { const int nblk = 2 * DM / 64, kb = r / nblk, nb = r % nblk, r0 = nb * 64; const int c0 = 128 * (r0 >> 8) + (r0 & 127);
                { LAS unsigned* scr = (LAS unsigned*)(lds + RING_OFF + wave * 16384); for (int t = 0; t < 4; ++t) p0_transpose_item<MK_NT_COPY != 0>(((r0 >> 7) & 1) ? w_glu_g : w_glu_v, DM, c0, WT_GLU, SSMW, r0, kb * 256 + 64 * t, scr, lane); } continue; } r -= I_GLU;
            if (r < I_CO) { const int nblk = DM / 64, kb = r / nblk, nb = r % nblk; { LAS unsigned* scr = (LAS unsigned*)(lds + RING_OFF + wave * 16384); for (int t = 0; t < 4; ++t) p0_transpose_item<MK_NT_COPY != 0>(w_conv_out, DM, nb * 64, WT_CO, CONVW, nb * 64, kb * 256 + 64 * t, scr, lane); } continue; } r -= I_CO;
            if (r < I_O) { const int nblk = DM / 64, kb = r / nblk, nb = r % nblk; { LAS unsigned* scr = (LAS unsigned*)(lds + RING_OFF + wave * 16384); for (int t = 0; t < 4; ++t) p0_transpose_item<MK_NT_COPY != 0>(w_o, DM, nb * 64, WT_O, DM, nb * 64, kb * 256 + 64 * t, scr, lane); } continue; } r -= I_O;
            { LAS unsigned* scr = (LAS unsigned*)(lds + RING_OFF + wave * 16384); const int nblk = DM / 64, kb = r / nblk, nb = r % nblk; p0_transpose_item<MK_NT_COPY != 0>(w_ffn_down, DM, nb * 64, WT_DN, DFF, nb * 64, kb * 64, scr, lane); }
        }
#ifdef MK_PROBE_C2
        }
#endif
      }
      if (NCONV == 0) __syncthreads();
      if (NCONV == 0 || bx < GG) {
        LAS float* red = (LAS float*)(lds + RING_OFF);
        for (int t = bx; t < NMETACOLS / 16; t += GG) {
            const int n0 = t * 16, kbase = wave * 512;
            const bf16* ap = HNM + (size_t)(lane & 15) * DM + kbase + 8 * (lane >> 4);
            const bf16* bp = WT_IN + (size_t)(n0 + (lane & 15)) * DM + kbase + 8 * (lane >> 4);
            f32x4 acc = (f32x4){0.f, 0.f, 0.f, 0.f};
#pragma unroll 4
            for (int k = 0; k < 512; k += 32) { const bf16x8 af = *(const GAS bf16x8*)(ap + k), bf = *(const GAS bf16x8*)(bp + k);
                acc = __builtin_amdgcn_mfma_f32_16x16x32_bf16(af, bf, acc, 0, 0, 0); }
#pragma unroll
            for (int r = 0; r < 4; ++r) red[(wave * 4 + r) * 64 + lane] = acc[r];
            __syncthreads();
            LAS float* pmt = red + 2048;
            if (tid < 256) { const int r = tid >> 6; float s = 0.f;
#pragma unroll
                for (int w = 0; w < 8; ++w) s += red[(w * 4 + r) * 64 + lane];
                PM[(size_t)(4 * (lane >> 4) + r) * NMETACOLS + n0 + (lane & 15)] = s; pmt[(4 * (lane >> 4) + r) * 16 + (lane & 15)] = s; }
            __syncthreads();
            if (t < NG && wave == 0) {
                const int gp = t * 64 + lane; const float lbr = LB[gp], lbi = LB[8192 + gp]; float bbr[16], bbi[16], sr = 0.f, si = 0.f;
#pragma unroll
                for (int h = 0; h < 16; ++h) { bbr[h] = BB[gp * 16 + h]; bbi[h] = BB[131072 + gp * 16 + h]; }
                for (int tau = 0; tau < NMETA; ++tau) { float br = 0.f, bi = 0.f;
#pragma unroll
                    for (int h = 0; h < 16; ++h) { const float uu = pmt[tau * 16 + h]; br = fmaf(bbr[h], uu, br); bi = fmaf(bbi[h], uu, bi); }
                    const float nr = lbr * sr - lbi * si + br, ni = lbr * si + lbi * sr + bi; sr = nr; si = ni; }
                SMETA[gp] = sr; SMETA[8192 + gp] = si;
            }
        }
        __syncthreads();
#ifdef MK_PROBE_G2
        for (int rep = 0; rep < 2; ++rep) {
#endif
        { pg8::Gemm g{(const bf16*)HN8, (const bf16*)WT_IN8, M, 8192, DM / 2}; typedef pg8::StaticOrderT<M, 8192, DM / 2> SO; SO S; S.init(GG, bx);
          pg8::EpiGateI8 E{SGA, SGB, SAH, SBIN};
          pg8::gemm_phase<pg8::EpiGateI8, SO, true, true, pg8::NoHook, true>(lds + RING_OFF, g, S, E); }
        { pg8::Gemm g{HN, WT_IN, M, 8192, DM}; typedef pg8::StaticOrderT<M, 8192, DM> SO; SO S; S.init(GG, NCONV ? bx : (bx + G / 2) % G);
          pg8::EpiProj E{U, Z, CB, SGA, SGB};
          pg8::gemm_phase<pg8::EpiProj, SO, true, true>(lds + RING_OFF, g, S, E); }
#ifdef MK_PROBE_G2
        }
#endif
      }
        if (BOTH(1)) GRID_BAR();
    }

    if (IN(2)) {
        const float* st_re = in_ptr(2); const float* st_im = in_ptr(3);
        {
            LAS unsigned char* wb = lds + RING_OFF + wave * SSM_WB; int par = 0;
            for (int it = bx; it < NBATCH * NG; it += G) {
                const int g = __builtin_amdgcn_readfirstlane(G == 256 ? 64 * ((bx >> 2) & 1) + 32 * (it >> 8) + (bx >> 3) : it >> 2), b = __builtin_amdgcn_readfirstlane(it & 3);
                ssm_tile<true>(wb, (LAS float*)(lds + TOT_OFF + par * 4096), U, YS, ws + WS_FR + (size_t)g * NFRAG * 1024, LB, SMETA, st_re, st_im, out, g, b, b * SEQ + 256 * wave, wave, lane);
                par ^= 1; }
            for (int it = bx; it < NG / 2; it += G) {
                const int g = __builtin_amdgcn_readfirstlane(2 * it + (wave >> 2)), tile = wave & 3;
                ssm_tile<false>(wb, (LAS float*)(lds + TOT_OFF), U, YS, ws + WS_FR + (size_t)g * NFRAG * 1024, LB, SMETA, st_re, st_im, out, g, 32 * tile, MP + 256 * tile, wave, lane); }
            if (bx >= NG / 2) {
                const float* st_cv = in_ptr(4); const float* conv_w = in_ptr(18);
            const int nthr = (G - NG / 2) * NWAVES * 64, t0 = ((bx - NG / 2) * NWAVES + wave) * 64 + lane;
            for (int it = t0; it < M * (CONVW / 8); it += nthr) {
                const int row = it >> 8, c = (it & 255) * 8;
                float z1[8], z2[8];
                const v4u z0w = *(const GAS v4u*)(Z + (size_t)row * CONVW + c), cbw = *(const GAS v4u*)(CB + (size_t)row * CONVW + c);
                int t; const float* sv1 = nullptr; const float* sv2 = nullptr; int m1 = -1, m2 = -1;
                if (row < MP) { t = row & (SEQ - 1); if (t < 1) m1 = 15; if (t < 2) m2 = 14 + t; }
                else { const int sI = row - MP, b = sI >> 3; t = sI & 7; if (t < 1) sv1 = st_cv + (size_t)(b * 2 + 1) * CONVW + c; if (t < 2) sv2 = st_cv + (size_t)(b * 2 + t) * CONVW + c; }
                if (t >= 1) { const v4u w = *(const GAS v4u*)(Z + (size_t)(row - 1) * CONVW + c); z1[0] = bflo(w.x); z1[1] = bfhi(w.x); z1[2] = bflo(w.y); z1[3] = bfhi(w.y); z1[4] = bflo(w.z); z1[5] = bfhi(w.z); z1[6] = bflo(w.w); z1[7] = bfhi(w.w); }
                else if (sv1) {
#pragma unroll
                    for (int e = 0; e < 8; ++e) z1[e] = sv1[e]; }
                else {
#pragma unroll
                    for (int e = 0; e < 8; ++e) { const int cc = c + e, q = 2048 + (cc >> 7) * 256 + (cc & 127); z1[e] = PM[(size_t)m1 * NMETACOLS + q] * PM[(size_t)m1 * NMETACOLS + q + 128]; } }
                if (t >= 2) { const v4u w = *(const GAS v4u*)(Z + (size_t)(row - 2) * CONVW + c); z2[0] = bflo(w.x); z2[1] = bfhi(w.x); z2[2] = bflo(w.y); z2[3] = bfhi(w.y); z2[4] = bflo(w.z); z2[5] = bfhi(w.z); z2[6] = bflo(w.w); z2[7] = bfhi(w.w); }
                else if (sv2) {
#pragma unroll
                    for (int e = 0; e < 8; ++e) z2[e] = sv2[e]; }
                else {
#pragma unroll
                    for (int e = 0; e < 8; ++e) { const int cc = c + e, q = 2048 + (cc >> 7) * 256 + (cc & 127); z2[e] = PM[(size_t)m2 * NMETACOLS + q] * PM[(size_t)m2 * NMETACOLS + q + 128]; } }
                const float z0[8] = {bflo(z0w.x), bfhi(z0w.x), bflo(z0w.y), bfhi(z0w.y), bflo(z0w.z), bfhi(z0w.z), bflo(z0w.w), bfhi(z0w.w)};
                const float cbv[8] = {bflo(cbw.x), bfhi(cbw.x), bflo(cbw.y), bfhi(cbw.y), bflo(cbw.z), bfhi(cbw.z), bflo(cbw.w), bfhi(cbw.w)};
                float y[8];
#pragma unroll
                for (int e = 0; e < 8; ++e) y[e] = cbv[e] * (conv_w[c + e] * z2[e] + conv_w[CONVW + c + e] * z1[e] + conv_w[2 * CONVW + c + e] * z0[e]);
                v4u o; o.x = pk2(y[0], y[1]); o.y = pk2(y[2], y[3]); o.z = pk2(y[4], y[5]); o.w = pk2(y[6], y[7]);
                *(GAS v4u*)(YC + (size_t)row * CONVW + c) = o;
            }
            for (int it = t0; it < (NBATCH + DBATCH) * 2 * CONVW; it += nthr) {
                const int c = it & (CONVW - 1), k = (it >> 11) & 1, sq = it >> 12;
                if (sq < NBATCH) out[OUT_PCV + (size_t)(sq * 2 + k) * CONVW + c] = bf1(Z[(size_t)(sq * SEQ + SEQ - 2 + k) * CONVW + c]);
                else { const int b = sq - NBATCH; out[OUT_SCV + (size_t)(b * 2 + k) * CONVW + c] = bf1(Z[(size_t)(MP + b * DSEQ + DSEQ - 2 + k) * CONVW + c]); }
            }
            }
        }
        if (BOTH(2)) GRID_BAR();
    }

    if (IN(3)) {
        pg8::Gemm g{YS, WT_GLU, M, 2 * DM, SSMW}; typedef pg8::StaticOrderT<M, 2 * DM, SSMW> SO; SO S; S.init(G, bx);
        pg8::EpiGlu E{SGA, M1};
        pg8::gemm_phase<pg8::EpiGlu, SO, true, true>(lds + RING_OFF, g, S, E);
        if (bx >= G / 2) {
            if (DN_P2 < (DFF / 64) * (DM / 64)) { const float* w_ffn_down = in_ptr(25); LAS unsigned* scr = (LAS unsigned*)(lds + RING_OFF + wave * 16384); constexpr int I_DN = (DFF / 64) * (DM / 64);
              for (int it = DN_P2 + ((bx - G / 2) * NWAVES + wave); it < I_DN; it += (G - G / 2) * NWAVES) { const int nblk = DM / 64, kb = it / nblk, nb = it % nblk;
                  p0_transpose_item<MK_NT_COPY != 0>(w_ffn_down, DM, nb * 64, WT_DN, DFF, nb * 64, kb * 64, scr, lane); } }
        }
        if (BOTH(3)) GRID_BAR();
    }
    if (IN(4)) {
        pg8::Gemm g{YC, WT_CO, M, DM, CONVW}; typedef pg8::TailSplitOrderT<MP, M, DM, CONVW, 4> SO; SO S; S.init(G, bx);
        pg8::EpiConvOut E{SGB, M1, MG, XT, MP, MSMP};
        pg8::gemm_phase<pg8::EpiConvOut, SO, true, true>(lds + RING_OFF, g, S, E);
        if (BOTH(4)) GRID_BAR();
    }
    if (IN(5)) {
        for (int it = gw; it < 2 * MSMP; it += NGW) {
            const int r = it >> 1, cbase = (it & 1) * 2048; const size_t ro = (size_t)(MP + r) * DM + cbase;
            const GAS v4u* xp = (const GAS v4u*)(XT + (size_t)r * DM + cbase) + lane;
            const GAS v4u* m1 = (const GAS v4u*)(M1 + ro) + lane; const GAS v2u* sg = (const GAS v2u*)((const GAS unsigned char*)SGB + ro) + lane; GAS v4u* mg = (GAS v4u*)(MG + ro) + lane;
#pragma unroll
            for (int j = 0; j < 4; ++j) { f32x4 a0, a1; pg8::unpack8(xp[64 * j], a0, a1);
#pragma unroll
                for (int p = 1; p < 4; ++p) { f32x4 c0, c1; pg8::unpack8(xp[64 * j + (size_t)p * MSMP * DM / 8], c0, c1); a0 = a0 + c0; a1 = a1 + c1; }
                f32x4 b0, b1, s0, s1; pg8::unpack8(m1[64 * j], b0, b1); { const v2u w = sg[64 * j]; pg8::u32x2 w2; w2.x = w.x; w2.y = w.y; pg8::unpack8u(w2, s0, s1); }
                mg[64 * j] = pg8::pack8(b0 + s0 * a0, b1 + s1 * a1); }
        }
        if (BOTH(5)) GRID_BAR();
    }
    if (IN(6)) {
        pg8::Gemm g{MG, WT_O, M, DM, DM}; typedef pg8::TailSplitOrderT<MP, M, DM, DM, 4> SO; SO S; S.init(G, bx);
        pg8::EpiBf16Parts E{OB, XT, MP, MSMP};
        pg8::gemm_phase<pg8::EpiBf16Parts, SO, true, true>(lds + RING_OFF, g, S, E);
        if (BOTH(6)) GRID_BAR();
    }
    if (IN(7)) {
        const float* x_prompt = in_ptr(0); const float* x_sample = in_ptr(1); const float* g_post_mix = in_ptr(21); const float* g_pre_ffn = in_ptr(22);
        for (int m = gw; m < M; m += NGW) {
            const GAS f32x4* xr = (const GAS f32x4*)(m < MP ? x_prompt + (size_t)m * DM : x_sample + (size_t)(m - MP) * DM) + 2 * lane;
            const GAS f32x4* g1 = (const GAS f32x4*)g_post_mix + 2 * lane; const GAS f32x4* g2 = (const GAS f32x4*)g_pre_ffn + 2 * lane;
            GAS v4u* ob = (GAS v4u*)(OB + (size_t)m * DM) + lane;
            f32x4 v[8][2]; float s = 0.f;
            if (m < MP) {
#pragma unroll
                for (int j = 0; j < 8; ++j) pg8::unpack8(ob[64 * j], v[j][0], v[j][1]);
            } else {
                const GAS v4u* xp = (const GAS v4u*)(XT + (size_t)(m - MP) * DM) + lane;
#pragma unroll
                for (int j = 0; j < 8; ++j) { f32x4 a0, a1; pg8::unpack8(xp[64 * j], a0, a1);
#pragma unroll
                    for (int p = 1; p < 4; ++p) { f32x4 c0, c1; pg8::unpack8(xp[64 * j + (size_t)p * MSMP * DM / 8], c0, c1); a0 = a0 + c0; a1 = a1 + c1; }
                    pg8::unpack8(pg8::pack8(a0, a1), v[j][0], v[j][1]); }
            }
#pragma unroll
            for (int j = 0; j < 8; ++j)
#pragma unroll
                for (int q = 0; q < 2; ++q) s += (v[j][q].x * v[j][q].x + v[j][q].y * v[j][q].y) + (v[j][q].z * v[j][q].z + v[j][q].w * v[j][q].w);
            const float rstd = 1.0f / sqrtf(wave_sum(s) * (1.0f / DM) + EPS);
            s = 0.f;
#pragma unroll
            for (int j = 0; j < 8; ++j)
#pragma unroll
                for (int q = 0; q < 2; ++q) { v[j][q] = xr[128 * j + q] + v[j][q] * rstd * g1[128 * j + q]; s += (v[j][q].x * v[j][q].x + v[j][q].y * v[j][q].y) + (v[j][q].z * v[j][q].z + v[j][q].w * v[j][q].w); }
            const float rstd2 = 1.0f / sqrtf(wave_sum(s) * (1.0f / DM) + EPS);
#pragma unroll
            for (int j = 0; j < 8; ++j) ob[64 * j] = pg8::pack8(v[j][0], v[j][1]);
            float amax = 0.f;
#pragma unroll
            for (int j = 0; j < 8; ++j)
#pragma unroll
                for (int q = 0; q < 2; ++q) { v[j][q] = v[j][q] * rstd2 * g2[128 * j + q];
                    amax = fmaxf(amax, fmaxf(fmaxf(fabsf(v[j][q].x), fabsf(v[j][q].y)), fmaxf(fabsf(v[j][q].z), fabsf(v[j][q].w)))); }
#pragma unroll
            for (int o = 1; o < 64; o <<= 1) amax = fmaxf(amax, __shfl_xor(amax, o));
            const float qs = amax > 0.f ? 127.0f / amax : 0.f;
            if (lane == 0) SA[m] = amax * (1.0f / 127.0f);
            GAS v2u* o8 = (GAS v2u*)(HF8 + (size_t)m * DM) + lane;
#pragma unroll
            for (int j = 0; j < 8; ++j) { v2u o;
                o.x = q8pack(v[j][0] * qs); o.y = q8pack(v[j][1] * qs); o8[64 * j] = o; }
        }
        if (BOTH(7)) GRID_BAR();
    }
    if (IN(8)) {
#if MK_P7_TAIL
        pg8::Gemm g{(const bf16*)HF8, (const bf16*)WT_UP8, M, 2 * DFF, DM / 2}; typedef pg8::RoundsTailOrderT<M, 2 * DFF, DM / 2, 8, 256> SO; SO S; S.init(bx);
        pg8::EpiSwiGluI8 E{HB, (pg8::f32x4*)(ws + WS_R5), SA, SB};
        if (G == 256) pg8::gemm_phase<pg8::EpiSwiGluI8, SO, true, true, pg8::NoHook, true>(lds + RING_OFF, g, S, E);
        if (BOTH(8)) GRID_BAR();
#else
        pg8::Gemm g{HF, WT_UP, M, 2 * DFF, DM}; typedef pg8::StaticOrderT<M, 2 * DFF, DM> SO; SO S; S.init(G, bx);
        pg8::EpiSwiGlu E{HB, (pg8::f32x4*)(ws + WS_R5)};
        pg8::gemm_phase<pg8::EpiSwiGlu, SO, true, true>(lds + RING_OFF, g, S, E);
#endif
    }
#if defined(MK_PROBE_SAMETILE)
    if (IN(9)) {
        struct SameTile { int pm, pn; __device__ __forceinline__ long long next(int i) const { return i < 12 ? pg8::pack_unit(pm, pn, 0, 0, DM / 64) : -1ll; } __device__ __forceinline__ int max_units() const { return 12; } };
        pg8::Gemm g{HF, WT_UP, M, 2 * DFF, DM}; SameTile S{MK_PROBE_SAMETILE ? (bx & 31) : 0, MK_PROBE_SAMETILE ? (bx >> 5) : 0}; pg8::EpiSwiGlu E{HB, (pg8::f32x4*)(ws + WS_R5)};
        pg8::gemm_phase<pg8::EpiSwiGlu, SameTile, true, true>(lds + RING_OFF, g, S, E);
        GRID_BAR();
    }
#endif
    if (IN(9)) {
#if MK_P7_TAIL
        typedef pg8::RoundsTailOrderT<M, 2 * DFF, DM / 2, 8, 256> SO;
        for (int it = bx; it < SO::nTail * 8; it += G) {
            const int tu = it >> 3, ai = (it >> 2) & 1, m = it & 3; const pg8::Unit u = pg8::unpack_unit(SO::WO::map(SO::R * 256 + tu));
            const int wr = wave >> 2, wc = wave & 3, fr = lane & 15, fq = lane >> 4;
            const pg8::u32x4* sp = (const pg8::u32x4*)(ws + WS_R5) + (size_t)(tu * 8) * 16 * 512 + tid;
            pg8::f32x4 v[2][2];
#pragma unroll
            for (int bj = 0; bj < 2; ++bj) { pg8::unpack8(sp[((ai * 2 + bj) * 4 + m) * 512], v[bj][0], v[bj][1]);
#pragma unroll
                for (int p = 1; p < 8; ++p) { pg8::f32x4 c0, c1; pg8::unpack8(sp[((size_t)p * 16 + ((ai * 2 + bj) * 4 + m)) * 512], c0, c1); v[bj][0] = v[bj][0] + c0; v[bj][1] = v[bj][1] + c1; } }
            const int row = u.pm * 256 + wr * 64 + fr + ai * 128 + m * 16, cq = u.pn * 256 + wc * 32 + 8 * fq; const float sa = SA[row];
            const pg8::f32x4 g0 = v[0][0] * (*(const pg8::f32x4*)(SB + cq) * sa), g1 = v[0][1] * (*(const pg8::f32x4*)(SB + cq + 4) * sa);
            const pg8::f32x4 u0 = v[1][0] * (*(const pg8::f32x4*)(SB + cq + 128) * sa), u1 = v[1][1] * (*(const pg8::f32x4*)(SB + cq + 132) * sa);
            const size_t off = (size_t)row * DFF + u.pn * 128 + wc * 32 + 8 * fq;
            *(pg8::u32x4*)(HB + off) = pg8::pack8(g0 * pg8::sigm4(g0) * u0, g1 * pg8::sigm4(g1) * u1);
        }
#endif
        if (BOTH(9)) GRID_BAR();
    }
    if (IN(10)) {
        pg8::Gemm g{HB, WT_DN, M, DM, DFF}; typedef pg8::TailSplitOrderT<MP, M, DM, DFF, 4> SO; SO S; S.init(G, bx);
        pg8::EpiBf16Parts E{FB, XT, MP, MSMP};
        pg8::gemm_phase<pg8::EpiBf16Parts, SO, true, true>(lds + RING_OFF, g, S, E);
        if (BOTH(10)) GRID_BAR();
    }
    if (IN(11)) {
        const float* g_post_ffn = in_ptr(26);
        for (int m = gw; m < M; m += NGW) {
            const GAS f32x4* g3 = (const GAS f32x4*)g_post_ffn + 2 * lane;
            const GAS v4u* ob = (const GAS v4u*)(OB + (size_t)m * DM) + lane; const GAS v4u* fb = (const GAS v4u*)(FB + (size_t)m * DM) + lane;
            GAS f32x4* yo = (GAS f32x4*)(out + OUT_Y + (size_t)m * DM) + 2 * lane;
            f32x4 v[8][2]; float s = 0.f;
            if (m < MP) {
#pragma unroll
                for (int j = 0; j < 8; ++j) pg8::unpack8(fb[64 * j], v[j][0], v[j][1]);
            } else {
                const GAS v4u* xp = (const GAS v4u*)(XT + (size_t)(m - MP) * DM) + lane;
#pragma unroll
                for (int j = 0; j < 8; ++j) { f32x4 a0, a1; pg8::unpack8(xp[64 * j], a0, a1);
#pragma unroll
                    for (int p = 1; p < 4; ++p) { f32x4 c0, c1; pg8::unpack8(xp[64 * j + (size_t)p * MSMP * DM / 8], c0, c1); a0 = a0 + c0; a1 = a1 + c1; }
                    v[j][0] = a0; v[j][1] = a1; }
            }
#pragma unroll
            for (int j = 0; j < 8; ++j)
#pragma unroll
                for (int q = 0; q < 2; ++q) s += (v[j][q].x * v[j][q].x + v[j][q].y * v[j][q].y) + (v[j][q].z * v[j][q].z + v[j][q].w * v[j][q].w);
            const float rstd = 1.0f / sqrtf(wave_sum(s) * (1.0f / DM) + EPS);
#pragma unroll
            for (int j = 0; j < 8; ++j) { f32x4 o0, o1; pg8::unpack8(ob[64 * j], o0, o1);
                yo[128 * j] = o0 + v[j][0] * rstd * g3[128 * j];
                yo[128 * j + 1] = o1 + v[j][1] * rstd * g3[128 * j + 1]; }
        }
    }
#undef IN
#undef BOTH
#undef GRID_BAR
}

extern "C" void kernel_launch(void* const* d_in, const int* in_sizes, int n_in, void* d_out, int out_size, void* d_ws, size_t ws_size, hipStream_t stream) {
    static int grid = 0;
    if (grid == 0) {
        if (n_in != 27 || out_size != (int)OUT_END || ws_size < WS_END) { fprintf(stderr, "kernel_launch: unexpected shapes: n_in %d out %d ws %zu (need %zu)\n", n_in, out_size, ws_size, (size_t)WS_END); grid = -1; return; }
        int dev = 0, cus = 0, per_cu = 0;
        if (hipGetDevice(&dev) != hipSuccess || hipDeviceGetAttribute(&cus, hipDeviceAttributeMultiprocessorCount, dev) != hipSuccess) { grid = -1; return; }
        if (hipFuncSetAttribute((const void*)fwd, hipFuncAttributeMaxDynamicSharedMemorySize, LDS_BYTES) != hipSuccess) { fprintf(stderr, "kernel_launch: hipFuncSetAttribute failed\n"); grid = -1; return; }
        if (hipOccupancyMaxActiveBlocksPerMultiprocessor(&per_cu, (const void*)fwd, NWAVES * 64, LDS_BYTES) != hipSuccess || per_cu < 1) { fprintf(stderr, "kernel_launch: occupancy query says %d\n", per_cu); (void)hipGetLastError(); grid = -1; return; }
        if (cus != 256) { fprintf(stderr, "kernel_launch: built for a 256-CU device, found %d CUs; nothing launched\n", cus); grid = -1; return; }
        grid = cus;
    }
    if (grid < 0) return;
    if (hipMemsetAsync((char*)d_ws + WS_CTL, 0, CTL_ZERO_BYTES, stream) != hipSuccess) return;
    Args a{};
    for (int i = 0; i < 27; ++i) a.in[i] = (const float*)d_in[i];
    a.out = (float*)d_out; a.ws = (unsigned char*)d_ws;
#if defined(MK_PROBE_DUP)
    a.ph_lo = 0; a.ph_hi = MK_PROBE_DUP + 1; hipLaunchKernelGGL(fwd, dim3(grid), dim3(NWAVES * 64), LDS_BYTES, stream, a);
    (void)hipMemsetAsync((char*)d_ws + WS_CTL, 0, CTL_ZERO_BYTES, stream);
    a.ph_lo = MK_PROBE_DUP; a.ph_hi = N_PHASES; hipLaunchKernelGGL(fwd, dim3(grid), dim3(NWAVES * 64), LDS_BYTES, stream, a);
#else
    for (int li = 0; li < N_LAUNCHES; ++li) {
        a.ph_lo = (N_LAUNCHES == 1) ? 0 : li; a.ph_hi = (N_LAUNCHES == 1) ? N_PHASES : li + 1;
        hipLaunchKernelGGL(fwd, dim3(grid), dim3(NWAVES * 64), LDS_BYTES, stream, a);
        if (hipPeekAtLastError() != hipSuccess) { fprintf(stderr, "kernel_launch: launch %d failed\n", li); break; }
    }
#endif
}
```

```cpp
#include <hip/hip_runtime.h>
#include <cstdio>
#include <cstdint>
#define MK_N_LAUNCHES 1
namespace pg8 {
#define PG8_LAS __attribute__((address_space(3)))
typedef unsigned short bf16_t;
typedef short bf16x8 __attribute__((ext_vector_type(8)));
typedef float f32x4 __attribute__((ext_vector_type(4)));
typedef unsigned u32x4 __attribute__((ext_vector_type(4)));
constexpr int BM = 256, BK = 64, HALF = 128, HTB = HALF * BK * 2  , STAGE_BYTES = 8 * HTB, NXCD = 8, WGM = 8;

__host__ __device__ __forceinline__ int lds_byte(int r, int c) { const int st = (r >> 4) * 2 + (c >> 5), rr = r & 15, cc = c & 31, ob = rr * 64 + cc * 2; return st * 1024 + (ob ^ (((ob >> 9) & 1) << 5)); }
__host__ __device__ __forceinline__ void stage_rc(int b, int& R, int& C) { const int st = b / 1024, sb = b % 1024, swz = sb ^ (((sb >> 9) & 1) << 5); R = (st >> 1) * 16 + swz / 64; C = (st & 1) * 32 + (swz % 64) / 2; }
__host__ __device__ __forceinline__ int perm32(int rho) { const int n = rho >> 4, i = rho & 15; return 8 * (i >> 2) + 4 * n + (i & 3); }

struct Unit { int pm, pn, kt0, nkt, part; };
struct Gemm { const bf16_t* A; const bf16_t* Bt; int M, N, K; };

__device__ __forceinline__ long long pack_unit(int pm, int pn, int part, int kt0, int nkt) { return (long long)(unsigned)(pm | (pn << 8) | (part << 16) | (kt0 << 20)) | ((long long)nkt << 32); }
__device__ __forceinline__ Unit unpack_unit(long long d) { const unsigned lo = (unsigned)d; Unit u; u.pm = lo & 255; u.pn = (lo >> 8) & 255; u.part = (lo >> 16) & 15; u.kt0 = lo >> 20; u.nkt = (int)(d >> 32); return u; }
template <int M_, int N_, int K_> struct StaticOrderT {
    static constexpr int nM = M_ / BM, nN = N_ / BM, nwg = nM * nN, nktf = K_ / BK;
    int G, c;
    __device__ __forceinline__ void init(int G_, int c_) { G = G_; c = c_; }
    __device__ __forceinline__ long long next(int i) const { const int L = i * G + c; return L >= nwg ? -1ll : map(L); }
    __device__ __forceinline__ int max_units() const { return (nwg + G - 1) / G; }
    __device__ __forceinline__ static long long map(int L) {
        int wgid = L; { constexpr int q = nwg / NXCD, r = nwg % NXCD; const int xcd = wgid % NXCD, off = wgid / NXCD; wgid = (xcd < r ? xcd * (q + 1) : r * (q + 1) + (xcd - r) * q) + off; }
        constexpr int nig = WGM * nN; const int gid = wgid / nig, fm = gid * WGM, gsz = (nM - fm) < WGM ? (nM - fm) : WGM;
        return pack_unit(fm + ((wgid % nig) % gsz), (wgid % nig) / gsz, 0, 0, nktf);
    }
};
template <int MW_, int M_, int N_, int K_, int SPLIT> struct TailSplitOrderT {
    typedef StaticOrderT<MW_, N_, K_> WO;
    static constexpr int nMw = MW_ / BM, nN = N_ / BM, nTail = (M_ - MW_) / BM * nN, np = K_ / BK / 2, base = np / SPLIT, rem = np % SPLIT;
    WO W; int nwhole;
    __device__ __forceinline__ void init(int G_, int c_) { W.init(G_, c_); nwhole = c_ < WO::nwg ? (WO::nwg - c_ + G_ - 1) / G_ : 0; }
    __device__ __forceinline__ long long next(int i) const {
        if (i < nwhole) return W.next(i);
        if (i != nwhole || W.c >= nTail * SPLIT) return -1ll;
        const int part = W.c % SPLIT, tu = W.c / SPLIT;
        return pack_unit(nMw + tu / nN, tu % nN, part, 2 * (part * base + (part < rem ? part : rem)), 2 * (base + (part < rem ? 1 : 0)));
    }
    __device__ __forceinline__ int max_units() const { return W.max_units() + 1; }
};
template <int M_, int N_, int K_, int SPLIT, int GRID> struct RoundsTailOrderT {
    typedef StaticOrderT<M_, N_, K_> WO;
    static constexpr int R = WO::nwg / GRID, nTail = WO::nwg % GRID, nkp = K_ / BK / SPLIT;
    static_assert(nTail * SPLIT <= GRID && nkp % 2 == 0 && nkp >= 2 && nkp * SPLIT * BK == K_, "RoundsTailOrderT geometry");
    int c;
    __device__ __forceinline__ void init(int c_) { c = c_; }
    __device__ __forceinline__ long long next(int i) const {
        if (i < R) return WO::map(i * GRID + c);
        if (i != R || c >= nTail * SPLIT) return -1ll;
        const Unit u = unpack_unit(WO::map(R * GRID + c / SPLIT)); const int part = c % SPLIT;
        return pack_unit(u.pm, u.pn, 1 + part, part * nkp, nkp);
    }
    __device__ __forceinline__ int max_units() const { return R + (nTail ? 1 : 0); }
};
__device__ __forceinline__ unsigned cvt_pk_bf16(float lo, float hi) { unsigned r; asm volatile("v_cvt_pk_bf16_f32 %0, %1, %2" : "=v"(r) : "v"(lo), "v"(hi)); return r; }
typedef float f32x2 __attribute__((ext_vector_type(2)));
struct NoHook { __device__ __forceinline__ void operator()() const {} };
typedef int i32x4 __attribute__((ext_vector_type(4)));
template <bool I8> __device__ __forceinline__ f32x4 mma1(bf16x8 b, bf16x8 a, f32x4 c) {
    if constexpr (I8) return __builtin_bit_cast(f32x4, __builtin_amdgcn_mfma_i32_16x16x64_i8(__builtin_bit_cast(i32x4, b), __builtin_bit_cast(i32x4, a), __builtin_bit_cast(i32x4, c), 0, 0, 0));
    else return __builtin_amdgcn_mfma_f32_16x16x32_bf16(b, a, c, 0, 0, 0);
}
template <class Epi, class Sched, bool ALIGN_EPI = false, bool SP2 = false, class Hook = NoHook, bool I8 = false>
__device__ __forceinline__ void gemm_phase(PG8_LAS unsigned char* lds, const Gemm g, const Sched& S, const Epi& E, const Hook& hook = Hook()) {
    const int tid = threadIdx.x, wid = __builtin_amdgcn_readfirstlane(tid >> 6), lane = tid & 63, wr = wid >> 2, wc = wid & 3, fr = lane & 15, fq = lane >> 4;
    const int K = g.K;
    unsigned voffA[2], voffB[2];
#pragma unroll
    for (int i = 0; i < 2; ++i) { int R, C; stage_rc(tid * 16 + i * 8192, R, C); const int Rb = Epi::PERM ? ((R & ~31) + perm32(R & 31)) : R;
        voffA[i] = (unsigned)(R * K + C) * 2u; voffB[i] = (unsigned)(Rb * K + C) * 2u; }
    const size_t kstep = (size_t)(BK * 2);
    const size_t hstep = (size_t)HALF * K * 2;
    const size_t tstep = 2 * hstep;
    const unsigned ldsw = (unsigned)wid * 1024u;
    const int aoff = lds_byte(wr * 64 + fr, fq * 8), boff = lds_byte(wc * 32 + fr, fq * 8);
#define PG8_SA(b, h) (((b) * 2 + (h)) * HTB)
#define PG8_SB(b, h) ((4 + (b) * 2 + (h)) * HTB)
#define PG8_STAGE(bufoff, gbase, voff) do { _Pragma("unroll") for (int _i = 0; _i < 2; ++_i) \
        __builtin_amdgcn_global_load_lds((const unsigned*)((const char*)(gbase) + (voff)[_i]), (PG8_LAS unsigned*)(lds + (bufoff) + ldsw + _i * 8192), 16, 0, 0); } while (0)
#define PG8_LDA(dst, b, h) do { _Pragma("unroll") for (int m = 0; m < 4; ++m) _Pragma("unroll") for (int k = 0; k < 2; ++k) dst[m][k] = *(const PG8_LAS bf16x8*)(lds + PG8_SA(b, h) + aoff + m * 2048 + k * 1024); } while (0)
#define PG8_LDB(dst, b, h) do { _Pragma("unroll") for (int n = 0; n < 2; ++n) _Pragma("unroll") for (int k = 0; k < 2; ++k) dst[n][k] = *(const PG8_LAS bf16x8*)(lds + PG8_SB(b, h) + boff + n * 2048 + k * 1024); } while (0)
#define PG8_MMA(ai, bj, At, Bt) do { __builtin_amdgcn_s_setprio(1); _Pragma("unroll") for (int k = 0; k < 2; ++k) _Pragma("unroll") for (int m = 0; m < 4; ++m) _Pragma("unroll") for (int n = 0; n < 2; ++n) \
        acc[ai][bj][m][n] = mma1<I8>(Bt[n][k], At[m][k], acc[ai][bj][m][n]); __builtin_amdgcn_s_setprio(0); } while (0)
#define PG8_WAIT_V(n) asm volatile("s_waitcnt vmcnt(" #n ")" ::: "memory")
#define PG8_WAIT_L(n) asm volatile("s_waitcnt lgkmcnt(" #n ")" ::: "memory")
#define PG8_BAR __builtin_amdgcn_s_barrier()
#define PG8_SCHED __builtin_amdgcn_sched_barrier(0)
    int ui = 0, c_pm, c_pn, c_kt0, c_nkt, c_part;
    int nhook = S.max_units() - 1;
    { const long long d0 = S.next(0); if (d0 < 0) { for (; nhook > 0; --nhook) hook(); return; } const Unit u0 = unpack_unit(d0); c_pm = u0.pm; c_pn = u0.pn; c_kt0 = u0.kt0; c_nkt = u0.nkt; c_part = u0.part; }
    f32x4 acc[2][2][4][2];
#pragma unroll
    for (int a = 0; a < 2; ++a)
#pragma unroll
        for (int b = 0; b < 2; ++b)
#pragma unroll
            for (int m = 0; m < 4; ++m)
#pragma unroll
                for (int n = 0; n < 2; ++n) acc[a][b][m][n] = (f32x4){0.f, 0.f, 0.f, 0.f};
    bf16x8 At[4][2], B0[2][2], B1[2][2];
    const char* cA = (const char*)g.A + (size_t)c_pm * tstep + (size_t)c_kt0 * kstep; const char* cB = (const char*)g.Bt + (size_t)c_pn * tstep + (size_t)c_kt0 * kstep;
    if constexpr (SP2) {
        PG8_STAGE(PG8_SB(0, 0), cB, voffB); PG8_STAGE(PG8_SB(0, 1), cB + hstep, voffB); PG8_STAGE(PG8_SA(0, 0), cA, voffA); PG8_STAGE(PG8_SA(0, 1), cA + hstep, voffA);
        if (wr == 1) PG8_BAR;
        PG8_WAIT_V(2); PG8_BAR;
        PG8_STAGE(PG8_SB(1, 0), cB + kstep, voffB); PG8_STAGE(PG8_SA(1, 0), cA + kstep, voffA); PG8_STAGE(PG8_SB(1, 1), cB + hstep + kstep, voffB);
        PG8_WAIT_V(6); PG8_BAR;
    } else {
        PG8_STAGE(PG8_SB(0, 0), cB, voffB); PG8_STAGE(PG8_SA(0, 0), cA, voffA); PG8_STAGE(PG8_SB(0, 1), cB + hstep, voffB); PG8_STAGE(PG8_SA(0, 1), cA + hstep, voffA);
        if (wr == 1) PG8_BAR;
        PG8_WAIT_V(4); PG8_BAR;
        PG8_STAGE(PG8_SB(1, 0), cB + kstep, voffB); PG8_STAGE(PG8_SA(1, 0), cA + kstep, voffA); PG8_STAGE(PG8_SB(1, 1), cB + hstep + kstep, voffB);
        PG8_WAIT_V(6); PG8_BAR;
    }
    for (;;) {
        bool has_next; const char* nA; const char* nB;
        { const long long dn = S.next(ui + 1); has_next = dn >= 0; const Unit nxt = unpack_unit(dn);
          nA = has_next ? (const char*)g.A + (size_t)nxt.pm * tstep + (size_t)nxt.kt0 * kstep : cA; nB = has_next ? (const char*)g.Bt + (size_t)nxt.pn * tstep + (size_t)nxt.kt0 * kstep : cB; }
        const int nt = c_nkt;
        for (int t = 0; t < nt; t += 2) {
            const bool last = (t == nt - 2);
            const char* a1 = cA + (size_t)(t + 1) * kstep;
            const char* a2 = last ? nA : cA + (size_t)(t + 2) * kstep; const char* b2 = last ? nB : cB + (size_t)(t + 2) * kstep;
            const char* a3 = a2 + kstep; const char* b3 = b2 + kstep;
            if constexpr (SP2) {
            PG8_LDB(B0, 0, 0); PG8_LDB(B1, 0, 1); PG8_SCHED; PG8_LDA(At, 0, 0); PG8_STAGE(PG8_SA(1, 1), a1 + hstep, voffA);
            PG8_WAIT_V(8); PG8_WAIT_L(0); PG8_BAR; PG8_MMA(0, 0, At, B0); PG8_MMA(0, 1, At, B1); PG8_BAR; PG8_SCHED;
            PG8_LDA(At, 0, 1); PG8_STAGE(PG8_SB(0, 0), b2, voffB); PG8_STAGE(PG8_SB(0, 1), b2 + hstep, voffB); PG8_STAGE(PG8_SA(0, 0), a2, voffA);
            PG8_WAIT_V(8); PG8_WAIT_L(0); PG8_BAR; PG8_MMA(1, 0, At, B0); PG8_MMA(1, 1, At, B1); PG8_BAR; PG8_SCHED;
            PG8_LDB(B0, 1, 0); PG8_LDB(B1, 1, 1); PG8_SCHED; PG8_LDA(At, 1, 0); PG8_STAGE(PG8_SA(0, 1), a2 + hstep, voffA);
            PG8_WAIT_V(8); PG8_WAIT_L(0); PG8_BAR; PG8_MMA(0, 0, At, B0); PG8_MMA(0, 1, At, B1); PG8_BAR; PG8_SCHED;
            PG8_LDA(At, 1, 1); PG8_STAGE(PG8_SB(1, 0), b3, voffB); PG8_STAGE(PG8_SB(1, 1), b3 + hstep, voffB); PG8_STAGE(PG8_SA(1, 0), a3, voffA);
            PG8_WAIT_V(8); PG8_WAIT_L(0); PG8_BAR; PG8_MMA(1, 0, At, B0); PG8_MMA(1, 1, At, B1); PG8_BAR; PG8_SCHED;
            } else {
            PG8_LDB(B0, 0, 0); PG8_SCHED; PG8_LDA(At, 0, 0); PG8_STAGE(PG8_SA(1, 1), a1 + hstep, voffA);
            PG8_WAIT_L(8); PG8_BAR; PG8_WAIT_L(0); PG8_MMA(0, 0, At, B0); PG8_BAR; PG8_SCHED;
            PG8_LDB(B1, 0, 1); PG8_STAGE(PG8_SB(0, 0), b2, voffB);
            PG8_BAR; PG8_WAIT_L(0); PG8_MMA(0, 1, At, B1); PG8_BAR;
            PG8_LDA(At, 0, 1); PG8_STAGE(PG8_SA(0, 0), a2, voffA);
            PG8_BAR; PG8_WAIT_L(0); PG8_MMA(1, 0, At, B0); PG8_BAR; PG8_SCHED;
            PG8_STAGE(PG8_SB(0, 1), b2 + hstep, voffB);
            PG8_WAIT_V(6); PG8_BAR; PG8_MMA(1, 1, At, B1); PG8_BAR;
            PG8_LDB(B0, 1, 0); PG8_SCHED; PG8_LDA(At, 1, 0); PG8_STAGE(PG8_SA(0, 1), a2 + hstep, voffA);
            PG8_WAIT_L(8); PG8_BAR; PG8_WAIT_L(0); PG8_MMA(0, 0, At, B0); PG8_BAR; PG8_SCHED;
            PG8_LDB(B1, 1, 1); PG8_STAGE(PG8_SB(1, 0), b3, voffB);
            PG8_BAR; PG8_WAIT_L(0); PG8_MMA(0, 1, At, B1); PG8_BAR;
            PG8_LDA(At, 1, 1); PG8_STAGE(PG8_SA(1, 0), a3, voffA);
            PG8_BAR; PG8_WAIT_L(0); PG8_MMA(1, 0, At, B0); PG8_BAR; PG8_SCHED;
            PG8_STAGE(PG8_SB(1, 1), b3 + hstep, voffB);
            PG8_WAIT_V(6); PG8_BAR; PG8_MMA(1, 1, At, B1); PG8_BAR;
            }
        }
        if constexpr (ALIGN_EPI) { if (wr == 0) PG8_BAR; }
        if constexpr (I8) {
#pragma unroll
            for (int a = 0; a < 2; ++a)
#pragma unroll
                for (int bq = 0; bq < 2; ++bq)
#pragma unroll
                    for (int m = 0; m < 4; ++m)
#pragma unroll
                        for (int n = 0; n < 2; ++n) acc[a][bq][m][n] = __builtin_convertvector(__builtin_bit_cast(i32x4, acc[a][bq][m][n]), f32x4); }
        if constexpr (!Epi::AFTER_DRAIN) { const Unit cu{c_pm, c_pn, c_kt0, c_nkt, c_part}; E(acc, cu, wr, wc, fr, fq); }
        if (!has_next) break;
        hook(); --nhook;
#pragma unroll
        for (int a = 0; a < 2; ++a)
#pragma unroll
            for (int b = 0; b < 2; ++b)
#pragma unroll
                for (int m = 0; m < 4; ++m)
#pragma unroll
                    for (int n = 0; n < 2; ++n) acc[a][b][m][n] = (f32x4){0.f, 0.f, 0.f, 0.f};
        ++ui; { int uj = ui; asm volatile("" : "+s"(uj)); const Unit u1 = unpack_unit(S.next(uj)); c_pm = u1.pm; c_pn = u1.pn; c_kt0 = u1.kt0; c_nkt = u1.nkt; c_part = u1.part; } cA = nA; cB = nB;
        if constexpr (ALIGN_EPI) { if (wr == 1) PG8_BAR; }
    }
    PG8_WAIT_V(0);
    if constexpr (!ALIGN_EPI) { if (wr == 0) PG8_BAR; }
    PG8_BAR;
    for (; nhook > 0; --nhook) hook();
    if constexpr (Epi::AFTER_DRAIN) { const Unit cu{c_pm, c_pn, c_kt0, c_nkt, c_part}; E.fused(acc, cu, wr, wc, fr, fq, lds, wid, lane); }
#undef PG8_SA
#undef PG8_SB
#undef PG8_STAGE
#undef PG8_LDA
#undef PG8_LDB
#undef PG8_MMA
#undef PG8_WAIT_V
#undef PG8_WAIT_L
#undef PG8_BAR
#undef PG8_SCHED
}
}
namespace pg8 {
typedef unsigned u32x2 __attribute__((ext_vector_type(2)));
__device__ __forceinline__ float bf_lo(unsigned w) { return __uint_as_float(w << 16); }
__device__ __forceinline__ float bf_hi(unsigned w) { return __uint_as_float(w & 0xffff0000u); }
__device__ __forceinline__ float sigm(float x) { return __builtin_amdgcn_rcpf(1.0f + __builtin_amdgcn_exp2f(-1.44269504089f * x)); }
__device__ __forceinline__ f32x4 sigm4(f32x4 v) { return (f32x4){sigm(v[0]), sigm(v[1]), sigm(v[2]), sigm(v[3])}; }
__device__ __forceinline__ u32x4 pack8(f32x4 v0, f32x4 v1) { u32x4 w; w.x = cvt_pk_bf16(v0[0], v0[1]); w.y = cvt_pk_bf16(v0[2], v0[3]); w.z = cvt_pk_bf16(v1[0], v1[1]); w.w = cvt_pk_bf16(v1[2], v1[3]); return w; }
__device__ __forceinline__ void unpack8(u32x4 w, f32x4& v0, f32x4& v1) { v0 = (f32x4){bf_lo(w.x), bf_hi(w.x), bf_lo(w.y), bf_hi(w.y)}; v1 = (f32x4){bf_lo(w.z), bf_hi(w.z), bf_lo(w.w), bf_hi(w.w)}; }

__device__ __forceinline__ unsigned pack4u(f32x4 v) { unsigned w = 0u;
    w = __builtin_amdgcn_cvt_pk_u8_f32(__builtin_rintf(v[0] * 255.0f), 0, w); w = __builtin_amdgcn_cvt_pk_u8_f32(__builtin_rintf(v[1] * 255.0f), 1, w);
    w = __builtin_amdgcn_cvt_pk_u8_f32(__builtin_rintf(v[2] * 255.0f), 2, w); w = __builtin_amdgcn_cvt_pk_u8_f32(__builtin_rintf(v[3] * 255.0f), 3, w); return w; }
__device__ __forceinline__ u32x2 pack8u(f32x4 v0, f32x4 v1) { u32x2 w; w.x = pack4u(v0); w.y = pack4u(v1); return w; }
__device__ __forceinline__ f32x4 unpack4u(unsigned w) { return (f32x4){(float)(w & 255u), (float)((w >> 8) & 255u), (float)((w >> 16) & 255u), (float)(w >> 24)} * (1.0f / 255.0f); }
__device__ __forceinline__ void unpack8u(u32x2 w, f32x4& v0, f32x4& v1) { v0 = unpack4u(w.x); v1 = unpack4u(w.y); }

#ifndef PG8_WT
#define PG8_WT 0
#endif
struct OutBuf { __amdgpu_buffer_rsrc_t r;
    __device__ __forceinline__ OutBuf(const void* base, size_t bytes) : r(__builtin_amdgcn_make_buffer_rsrc((void*)base, (short)0, (int)bytes, 0x00020000)) {}
    __device__ __forceinline__ void st(unsigned voff, unsigned soff, u32x4 v) const { __builtin_amdgcn_raw_buffer_store_b128(v, r, (int)(voff + soff), 0, PG8_WT); }
    __device__ __forceinline__ u32x4 ld(unsigned voff) const { return __builtin_amdgcn_raw_buffer_load_b128(r, (int)voff, 0, 0); }
    __device__ __forceinline__ void st8(unsigned voff, u32x2 v) const { __builtin_amdgcn_raw_buffer_store_b64(v, r, (int)voff, 0, PG8_WT); }
    __device__ __forceinline__ u32x2 ld8(unsigned voff) const { return __builtin_amdgcn_raw_buffer_load_b64(r, (int)voff, 0, 0); }
    __device__ __forceinline__ void stf(unsigned voff, unsigned soff, f32x4 v) const { __builtin_amdgcn_raw_buffer_store_b128(__builtin_bit_cast(u32x4, v), r, (int)(voff + soff), 0, PG8_WT); } };
struct EpiProj {
    static constexpr bool PERM = true, AFTER_DRAIN = false;
    bf16_t *U, *Z, *CB, *SGA, *SGB;
    __device__ __forceinline__ void operator()(const f32x4 (&acc)[2][2][4][2], const Unit& u, int wr, int wc, int fr, int fq) const {
        const int row0 = u.pm * BM + wr * 64 + fr, cw = wc * 32 + 8 * fq, pn = u.pn;
        if (pn >= 8 && pn < 24) {
            const OutBuf ob(Z, (size_t)9216 * 2048 * 2); const unsigned v0 = (unsigned)(row0 * 2048 + (pn - 8) * 128 + cw) * 2u;
#pragma unroll
            for (int ai = 0; ai < 2; ++ai)
#pragma unroll
                for (int m = 0; m < 4; ++m) ob.st(v0, (unsigned)(ai * HALF + m * 16) * 2048u * 2u, pack8(acc[ai][0][m][0] * acc[ai][1][m][0], acc[ai][0][m][1] * acc[ai][1][m][1]));
        } else {
            bf16_t* base; int ldc, cb; bool sg;
            if (pn < 8) { base = U; cb = pn * 256; ldc = 2048; sg = false; }
            else if (pn < 32) { base = CB; cb = (pn - 24) * 256; ldc = 2048; sg = false; }
            else if (pn < 48) { base = SGA; cb = (pn - 32) * 256; ldc = 4096; sg = true; }
            else { base = SGB; cb = (pn - 48) * 256; ldc = 4096; sg = true; }
            const OutBuf ob(base, (size_t)9216 * ldc * 2); const unsigned v0 = (unsigned)(row0 * ldc + cb + cw) * 2u;
#pragma unroll
            for (int ai = 0; ai < 2; ++ai)
#pragma unroll
                for (int m = 0; m < 4; ++m)
#pragma unroll
                    for (int bj = 0; bj < 2; ++bj) { f32x4 v0f = acc[ai][bj][m][0], v1f = acc[ai][bj][m][1];
                        if (sg) { v0f = sigm4(v0f); v1f = sigm4(v1f); }
                        ob.st(v0, (unsigned)((ai * HALF + m * 16) * ldc + bj * HALF) * 2u, pack8(v0f, v1f)); }
        }
    }
};
struct EpiGlu {
    static constexpr bool PERM = true, AFTER_DRAIN = false;
    const bf16_t* SGA; bf16_t* M1;
    __device__ __forceinline__ void operator()(const f32x4 (&acc)[2][2][4][2], const Unit& u, int wr, int wc, int fr, int fq) const {
        const int row0 = u.pm * BM + wr * 64 + fr, col = u.pn * 128 + wc * 32 + 8 * fq; const OutBuf ob(M1, (size_t)9216 * 4096 * 2), ib(SGA, (size_t)9216 * 4096);
#pragma unroll
        for (int ai = 0; ai < 2; ++ai)
#pragma unroll
            for (int m = 0; m < 4; ++m) { const unsigned off = (unsigned)((row0 + ai * HALF + m * 16) * 4096 + col);
                f32x4 s0, s1; unpack8u(ib.ld8(off), s0, s1);
                const f32x4 o0 = s0 * acc[ai][0][m][0] * sigm4(acc[ai][1][m][0]), o1 = s1 * acc[ai][0][m][1] * sigm4(acc[ai][1][m][1]);
                ob.st((unsigned)off * 2u, 0u, pack8(o0, o1)); }
    }
};
struct EpiConvOut {
    static constexpr bool PERM = true, AFTER_DRAIN = false;
    const bf16_t *SGB, *M1; bf16_t* MG; bf16_t* XT; int MW, MT;
    __device__ __forceinline__ void operator()(const f32x4 (&acc)[2][2][4][2], const Unit& u, int wr, int wc, int fr, int fq) const {
        const int row0 = u.pm * BM + wr * 64 + fr, col = u.pn * BM + wc * 32 + 8 * fq; const OutBuf ob(MG, (size_t)9216 * 4096 * 2), ig(SGB, (size_t)9216 * 4096), im(M1, (size_t)9216 * 4096 * 2);
        if (row0 >= MW) {
            const OutBuf xb(XT, (size_t)4 * MT * 4096 * 2); const unsigned v0 = (unsigned)((u.part * MT + (row0 - MW)) * 4096 + col) * 2u;
#pragma unroll
            for (int ai = 0; ai < 2; ++ai)
#pragma unroll
                for (int m = 0; m < 4; ++m)
#pragma unroll
                    for (int bj = 0; bj < 2; ++bj) xb.st(v0, (unsigned)((ai * HALF + m * 16) * 4096 + bj * HALF) * 2u, pack8(acc[ai][bj][m][0], acc[ai][bj][m][1]));
            return;
        }
#pragma unroll
        for (int ai = 0; ai < 2; ++ai)
#pragma unroll
            for (int m = 0; m < 4; ++m)
#pragma unroll
                for (int bj = 0; bj < 2; ++bj) { const unsigned off = (unsigned)((row0 + ai * HALF + m * 16) * 4096 + col + bj * HALF);
                    f32x4 s0, s1, a0, a1; unpack8u(ig.ld8(off), s0, s1); unpack8(im.ld(off * 2u), a0, a1);
                    ob.st((unsigned)off * 2u, 0u, pack8(a0 + s0 * acc[ai][bj][m][0], a1 + s1 * acc[ai][bj][m][1])); }
    }
};
struct EpiBf16Parts {
    static constexpr bool PERM = true, AFTER_DRAIN = false;
    bf16_t* C; bf16_t* XT; int MW, MT;
    __device__ __forceinline__ void operator()(const f32x4 (&acc)[2][2][4][2], const Unit& u, int wr, int wc, int fr, int fq) const {
        const int row0 = u.pm * BM + wr * 64 + fr, col = u.pn * BM + wc * 32 + 8 * fq;
        if (row0 < MW) {
            const OutBuf ob(C, (size_t)9216 * 4096 * 2); const unsigned v0 = (unsigned)(row0 * 4096 + col) * 2u;
#pragma unroll
            for (int ai = 0; ai < 2; ++ai)
#pragma unroll
                for (int m = 0; m < 4; ++m)
#pragma unroll
                    for (int bj = 0; bj < 2; ++bj) ob.st(v0, (unsigned)((ai * HALF + m * 16) * 4096 + bj * HALF) * 2u, pack8(acc[ai][bj][m][0], acc[ai][bj][m][1]));
        } else {
            const OutBuf ob(XT, (size_t)4 * MT * 4096 * 2); const unsigned v0 = (unsigned)((u.part * MT + (row0 - MW)) * 4096 + col) * 2u;
#pragma unroll
            for (int ai = 0; ai < 2; ++ai)
#pragma unroll
                for (int m = 0; m < 4; ++m)
#pragma unroll
                    for (int bj = 0; bj < 2; ++bj) ob.st(v0, (unsigned)((ai * HALF + m * 16) * 4096 + bj * HALF) * 2u, pack8(acc[ai][bj][m][0], acc[ai][bj][m][1]));
        }
    }
};
struct EpiSwiGlu {
    static constexpr bool PERM = true, AFTER_DRAIN = false;
    bf16_t* H; f32x4* XS;
    __device__ __forceinline__ void operator()(const f32x4 (&acc)[2][2][4][2], const Unit& u, int wr, int wc, int fr, int fq) const {
        if (u.part != 0) {
            const OutBuf ob(XS, (size_t)192 * 16 * 512 * 16); const unsigned v0 = ((unsigned)blockIdx.x * 16u * 512u + threadIdx.x) * 16u;
#pragma unroll
            for (int ai = 0; ai < 2; ++ai)
#pragma unroll
                for (int bj = 0; bj < 2; ++bj)
#pragma unroll
                    for (int m = 0; m < 4; ++m) ob.st(v0, (unsigned)(((ai * 2 + bj) * 4 + m) * 8192), pack8(acc[ai][bj][m][0], acc[ai][bj][m][1]));
            return;
        }
        const int row0 = u.pm * BM + wr * 64 + fr, col = u.pn * 128 + wc * 32 + 8 * fq;
        const OutBuf ob(H, (size_t)9216 * 11008 * 2); const unsigned v0 = (unsigned)(row0 * 11008 + col) * 2u;
#pragma unroll
        for (int ai = 0; ai < 2; ++ai)
#pragma unroll
            for (int m = 0; m < 4; ++m) { const f32x4 g0 = acc[ai][0][m][0], g1 = acc[ai][0][m][1];
                ob.st(v0, (unsigned)((ai * HALF + m * 16) * 11008) * 2u, pack8(g0 * sigm4(g0) * acc[ai][1][m][0], g1 * sigm4(g1) * acc[ai][1][m][1])); }
    }
};
struct EpiGateI8 {
    static constexpr bool PERM = true, AFTER_DRAIN = false;
    bf16_t *SGA, *SGB; const float* SA; const float* SB;
    __device__ __forceinline__ void operator()(const f32x4 (&acc)[2][2][4][2], const Unit& u, int wr, int wc, int fr, int fq) const {
        const int row0 = u.pm * BM + wr * 64 + fr, cw = wc * 32 + 8 * fq, cq = u.pn * BM + cw;
        const OutBuf ob(u.pn < 16 ? SGA : SGB, (size_t)9216 * 4096); const unsigned v0 = (unsigned)(row0 * 4096 + (u.pn & 15) * 256 + cw);
        f32x4 sb[2][2];
#pragma unroll
        for (int bj = 0; bj < 2; ++bj) { sb[bj][0] = *(const f32x4*)(SB + cq + bj * HALF); sb[bj][1] = *(const f32x4*)(SB + cq + bj * HALF + 4); }
#pragma unroll
        for (int ai = 0; ai < 2; ++ai)
#pragma unroll
            for (int m = 0; m < 4; ++m) { const float sa = SA[row0 + ai * HALF + m * 16];
#pragma unroll
                for (int bj = 0; bj < 2; ++bj)
                    ob.st8(v0 + (unsigned)((ai * HALF + m * 16) * 4096 + bj * HALF), pack8u(sigm4(acc[ai][bj][m][0] * (sb[bj][0] * sa)), sigm4(acc[ai][bj][m][1] * (sb[bj][1] * sa)))); }
    }
};
struct EpiSwiGluI8 {
    static constexpr bool PERM = true, AFTER_DRAIN = false;
    bf16_t* H; f32x4* XS; const float* SA; const float* SB;
    __device__ __forceinline__ void operator()(const f32x4 (&acc)[2][2][4][2], const Unit& u, int wr, int wc, int fr, int fq) const {
        if (u.part != 0) {
            const OutBuf ob(XS, (size_t)192 * 16 * 512 * 16); const unsigned v0 = ((unsigned)blockIdx.x * 16u * 512u + threadIdx.x) * 16u;
#pragma unroll
            for (int ai = 0; ai < 2; ++ai)
#pragma unroll
                for (int bj = 0; bj < 2; ++bj)
#pragma unroll
                    for (int m = 0; m < 4; ++m) ob.st(v0, (unsigned)(((ai * 2 + bj) * 4 + m) * 8192), pack8(acc[ai][bj][m][0], acc[ai][bj][m][1]));
            return;
        }
        const int row0 = u.pm * BM + wr * 64 + fr, col = u.pn * 128 + wc * 32 + 8 * fq, cq = u.pn * BM + wc * 32 + 8 * fq;
        const f32x4 sg0 = *(const f32x4*)(SB + cq), sg1 = *(const f32x4*)(SB + cq + 4), su0 = *(const f32x4*)(SB + cq + HALF), su1 = *(const f32x4*)(SB + cq + HALF + 4);
        const OutBuf ob(H, (size_t)9216 * 11008 * 2); const unsigned v0 = (unsigned)(row0 * 11008 + col) * 2u;
#pragma unroll
        for (int ai = 0; ai < 2; ++ai)
#pragma unroll
            for (int m = 0; m < 4; ++m) { const float sa = SA[row0 + ai * HALF + m * 16];
                const f32x4 g0 = acc[ai][0][m][0] * (sg0 * sa), g1 = acc[ai][0][m][1] * (sg1 * sa);
                ob.st(v0, (unsigned)((ai * HALF + m * 16) * 11008) * 2u, pack8(g0 * sigm4(g0) * (acc[ai][1][m][0] * (su0 * sa)), g1 * sigm4(g1) * (acc[ai][1][m][1] * (su1 * sa)))); }
    }
};
}
constexpr int NWAVES = 8;
constexpr int DM = 4096, NBATCH = 4, SEQ = 2048, NMETA = 16, DBATCH = 128, DSEQ = 8;
constexpr int MP = NBATCH * SEQ, MSMP = DBATCH * DSEQ, M = MP + MSMP;
constexpr int SSMW = 2048, NG = 128, GS = 16, NST = 64, CONVW = 2048, DFF = 11008, INCOLS = 16384;
constexpr int NMETACOLS = 6144;
constexpr float EPS = 1e-6f;
#ifndef MK_N_LAUNCHES
#define MK_N_LAUNCHES 1
#endif
constexpr int N_PHASES = 12;
#ifndef MK_NCONV
#define MK_NCONV 0
#endif
#ifndef MK_P7_TAIL
#define MK_P7_TAIL 1
#endif
constexpr int NCONV = MK_NCONV;
constexpr int N_LAUNCHES = MK_N_LAUNCHES;

constexpr size_t OUT_Y = 0, OUT_PRE = (size_t)M * DM, OUT_PIM = OUT_PRE + NBATCH * NG * NST, OUT_PCV = OUT_PIM + NBATCH * NG * NST,
                 OUT_SRE = OUT_PCV + NBATCH * 2 * CONVW, OUT_SIM = OUT_SRE + (size_t)DBATCH * NG * NST, OUT_SCV = OUT_SIM + (size_t)DBATCH * NG * NST,
                 OUT_END = OUT_SCV + (size_t)DBATCH * 2 * CONVW;

constexpr size_t MiB = 1u << 20;
constexpr size_t WS_CTL = 0, CTL_ZERO_BYTES = 64 * 1024;
constexpr size_t WS_LB = 1 * MiB;
constexpr size_t WS_BB = WS_LB + 256 * 1024;
constexpr size_t WS_PM = WS_BB + 1 * MiB;
constexpr size_t WS_HNM = WS_PM + 384 * 1024;
constexpr size_t WS_SMETA = WS_HNM + 128 * 1024;
constexpr size_t WS_SS1 = 3 * MiB;
constexpr size_t WS_SS2 = WS_SS1 + (size_t)M * 64 * 4;
constexpr size_t WS_WIN = 8 * MiB;
constexpr size_t WS_WGLU = WS_WIN + (size_t)INCOLS * DM * 2;
constexpr size_t WS_WCO = WS_WGLU + (size_t)2 * DM * SSMW * 2;
constexpr size_t WS_WO = WS_WCO + (size_t)DM * CONVW * 2;
constexpr size_t WS_WUP = WS_WO + (size_t)DM * DM * 2;
constexpr size_t WS_WDN = WS_WUP + (size_t)2 * DFF * DM * 2;
constexpr size_t WS_ACT = WS_WDN + (size_t)DM * DFF * 2;
constexpr size_t A36 = (size_t)M * 2048 * 2, A72 = 2 * A36;
constexpr size_t WS_R0 = WS_ACT;
constexpr size_t WS_R1 = WS_R0 + A72;
constexpr size_t WS_R2 = WS_R1 + A72;
constexpr size_t WS_R3 = WS_R2 + A36;
constexpr size_t WS_R4 = WS_R3 + A72;
constexpr size_t WS_R5 = WS_R4 + A72;
constexpr size_t WS_R6 = WS_R5 + A72;
constexpr size_t WS_END = WS_R6 + 2 * A72;
constexpr size_t WS_FR = WS_R6;
constexpr int NFRAG = 84;
constexpr size_t WS_H = WS_R1;
static_assert(WS_SS2 + (size_t)M * 64 * 4 <= WS_WIN && WS_SMETA + 64 * 1024 <= WS_SS1, "small region");
static_assert(WS_H + (size_t)M * DFF * 2 <= WS_R5, "H overlay");
static_assert(WS_END <= 1024 * MiB, "workspace budget");
constexpr int CW_BAR = 1024;
static_assert((CW_BAR + 5504) * 4 <= (int)CTL_ZERO_BYTES, "barrier words inside the memset region");

constexpr int RING_OFF = 0, RING_BYTES = 131072;
constexpr int SSM_WB = 32 * 528;
constexpr int TOT_OFF = 8 * SSM_WB;
constexpr int MISC_OFF = 147456 - 256;
static_assert(TOT_OFF + 8192 <= MISC_OFF && RING_BYTES <= MISC_OFF, "LDS map");
constexpr int LDS_BYTES = 147456;

#define GAS __attribute__((address_space(1)))
#define LAS __attribute__((address_space(3)))
typedef unsigned short bf16;
typedef unsigned v4u __attribute__((ext_vector_type(4)));
typedef unsigned v2u __attribute__((ext_vector_type(2)));
typedef float f32x4 __attribute__((ext_vector_type(4)));
typedef short bf16x8 __attribute__((ext_vector_type(8)));
#define LDS_WAIT() asm volatile("s_waitcnt lgkmcnt(0)" ::: "memory")
#define VM_WAIT() asm volatile("s_waitcnt vmcnt(0)" ::: "memory")
__device__ __forceinline__ unsigned f2bf(float f) { unsigned u = __builtin_bit_cast(unsigned, f); return (u + 0x7fffu + ((u >> 16) & 1u)) >> 16; }
__device__ __forceinline__ unsigned pk2(float lo, float hi) { return f2bf(lo) | (f2bf(hi) << 16); }
__device__ __forceinline__ float bflo(unsigned w) { return __uint_as_float(w << 16); }
__device__ __forceinline__ float bfhi(unsigned w) { return __uint_as_float(w & 0xffff0000u); }
__device__ __forceinline__ float bf1(bf16 b) { return __uint_as_float(((unsigned)b) << 16); }
#define XB_TMO      128
#define XB_XCNT(j)  (256  + 64 * (j))
#define XB_XSUB(j)  (1280 + 64 * (j))
#define XB_XGEN(j)  (2304 + 64 * (j))
#define XB_TOP      3328
#define XB_TOPGEN   3392
#define XCD_BAR_WORDS 3456
#define XB_LSUB(j)  (3456 + 64 * (j))
#define XB_LGEN(j)  (4480 + 64 * (j))
#define XCD_ALL_WORDS 5504
#define XB_SPIN_CAP (1u << 18)

__device__ __forceinline__ unsigned xb_ld(unsigned* p)              { return __hip_atomic_load(p, __ATOMIC_RELAXED, __HIP_MEMORY_SCOPE_AGENT); }
__device__ __forceinline__ unsigned xb_add(unsigned* p, unsigned v) { return __hip_atomic_fetch_add(p, v, __ATOMIC_RELAXED, __HIP_MEMORY_SCOPE_AGENT); }
__device__ __forceinline__ unsigned xb_xcc_id() { return (unsigned)__builtin_amdgcn_s_getreg((3 << 11) | 20) & 0xFu; }
#define XB_SPIN(cond, bar) do { unsigned _sp = 0; while (cond) { __builtin_amdgcn_s_sleep(1); \
    if ((++_sp & 255u) == 0u) { if (xb_ld(&(bar)[XB_TMO])) break; if (_sp > XB_SPIN_CAP) { atomicAdd(&(bar)[XB_TMO], 1u); break; } } } } while (0)

struct XcdBarrier {
    unsigned* bar; unsigned x;
    volatile LAS unsigned* st;
};

__device__ __forceinline__ XcdBarrier xcd_barrier_post(unsigned* bar, volatile LAS unsigned* st) {
    XcdBarrier b; b.bar = bar; b.x = xb_xcc_id(); b.st = st;
    if (threadIdx.x == 0) (void)xb_add(&bar[XB_XCNT(b.x)], 1u);
    return b;
}
__device__ __forceinline__ void xcd_barrier_complete(unsigned* bar, unsigned x, unsigned& nloc, unsigned& nx) {
    const unsigned G = gridDim.x * gridDim.y * gridDim.z;
    unsigned sum, cnt, mine, sp = 0u;
    for (;;) {
        sum = 0u; cnt = 0u; mine = 0u;
#pragma unroll
        for (unsigned j = 0; j < 16; ++j) { const unsigned c = xb_ld(&bar[XB_XCNT(j)]); sum += c; cnt += (c > 0u) ? 1u : 0u; mine = (j == x) ? c : mine; }
        if (sum == G) break;
        __builtin_amdgcn_s_sleep(1);
        if ((++sp & 255u) == 0u) { if (xb_ld(&bar[XB_TMO])) break; if (sp > XB_SPIN_CAP) { atomicAdd(&bar[XB_TMO], 1u); break; } }
    }
    nloc = mine > 0u ? mine : 1u; nx = cnt > 0u ? cnt : 1u;
}

__device__ __forceinline__ void xcd_barrier(const XcdBarrier& b) {
    asm volatile("s_waitcnt vmcnt(0)" ::: "memory");
    __syncthreads();
    if (threadIdx.x == 0) {
        unsigned* bar = b.bar;
        __builtin_amdgcn_s_waitcnt(0);
        unsigned nloc = b.st[0], nx = b.st[1];
        if (nloc == 0u) { xcd_barrier_complete(bar, b.x, nloc, nx); b.st[0] = nloc; b.st[1] = nx; }
        const unsigned old = xb_add(&bar[XB_XSUB(b.x)], 1u);
        const unsigned gen = old / nloc;
        if (old + 1u == (gen + 1u) * nloc) {
            __builtin_amdgcn_fence(__ATOMIC_RELEASE, "agent");
            asm volatile("s_waitcnt vmcnt(0)" ::: "memory");
            const unsigned og = xb_add(&bar[XB_TOP], 1u);
            const unsigned tg = og / nx;
            if (og + 1u == (tg + 1u) * nx) xb_add(&bar[XB_TOPGEN], 1u);
            else XB_SPIN(xb_ld(&bar[XB_TOPGEN]) == tg, bar);
            __builtin_amdgcn_fence(__ATOMIC_ACQUIRE, "agent");
            xb_add(&bar[XB_XGEN(b.x)], 1u);
            asm volatile("s_waitcnt vmcnt(0)" ::: "memory");
        } else {
            XB_SPIN(xb_ld(&bar[XB_XGEN(b.x)]) == gen, bar);
            __builtin_amdgcn_fence(__ATOMIC_ACQUIRE, "agent");
            asm volatile("s_waitcnt vmcnt(0)" ::: "memory");
        }
    }
    __syncthreads();
}
__device__ __forceinline__ void xcd_local_sync(const XcdBarrier& b) {
    asm volatile("" ::: "memory"); __builtin_amdgcn_s_barrier(); asm volatile("" ::: "memory");
    if (threadIdx.x == 0) {
        unsigned* bar = b.bar; unsigned nloc = b.st[0], nx = b.st[1];
        if (nloc == 0u) { xcd_barrier_complete(bar, b.x, nloc, nx); b.st[0] = nloc; b.st[1] = nx; }
        const unsigned old = xb_add(&bar[XB_LSUB(b.x)], 1u), gen = old / nloc;
        if (old + 1u == (gen + 1u) * nloc) xb_add(&bar[XB_LGEN(b.x)], 1u);
        else XB_SPIN(xb_ld(&bar[XB_LGEN(b.x)]) == gen, bar);
    }
    asm volatile("" ::: "memory"); __builtin_amdgcn_s_barrier(); asm volatile("" ::: "memory");
}
struct XcdSyncHook { XcdBarrier b; __device__ __forceinline__ void operator()() const { xcd_local_sync(b); } };
__device__ __forceinline__ float wave_sum(float v) {
#pragma unroll
    for (int o = 1; o < 64; o <<= 1) v += __shfl_xor(v, o);
    return v;
}
__device__ __forceinline__ float gelu_tanh(float x) {
    const float y = 0.7978845608028654f * (x + 0.044715f * x * x * x);
    const float e = __builtin_amdgcn_exp2f(2.885390081777927f * y);
    const float th = 1.0f - 2.0f * __builtin_amdgcn_rcpf(e + 1.0f);
    return 0.5f * x * (1.0f + th);
}
#ifndef MK_NT_COPY
#define MK_NT_COPY 1
#endif
#ifndef MK_WDROP
#define MK_WDROP 0
#endif
__device__ __forceinline__ unsigned f2bfw(float f) { unsigned u = __builtin_bit_cast(unsigned, f); const int sh = 16 + MK_WDROP; return ((u + ((1u << (sh - 1)) - 1u) + ((u >> sh) & 1u)) >> sh) << MK_WDROP; }
__device__ __forceinline__ unsigned pk2w(float lo, float hi) { return MK_WDROP ? (f2bfw(lo) | (f2bfw(hi) << 16)) : pk2(lo, hi); }
template <bool NT = false> __device__ __forceinline__ void p0_transpose_item(const float* W, int Nsrc, int c0, bf16* WT, int K, int r0, int k0, LAS unsigned* scr, int lane) {
    const float* src = W + (size_t)k0 * Nsrc + c0 + lane;
    float v[64];
#pragma unroll
    for (int i = 0; i < 64; ++i) v[i] = __builtin_nontemporal_load(src + (size_t)i * Nsrc);
#pragma unroll
    for (int i = 0; i < 32; ++i) scr[i * 66 + lane] = pk2w(v[2 * i], v[2 * i + 1]);
    LDS_WAIT(); asm volatile("" ::: "memory");
    const int c = lane & 7;
#pragma unroll
    for (int j = 0; j < 8; ++j) { const int n = (lane >> 3) + 8 * j; const LAS unsigned* s = scr + (4 * c) * 66 + n;
        v4u o; o.x = s[0]; o.y = s[66]; o.z = s[132]; o.w = s[198];
        GAS v4u* d = (GAS v4u*)(WT + (size_t)(r0 + n) * K + k0 + 8 * c); if (NT) __builtin_nontemporal_store(o, d); else *d = o; }
    LDS_WAIT(); asm volatile("" ::: "memory");
}
#define TL_LOAD(v, t) do { _Pragma("unroll") for (int i = 0; i < 16; ++i) v[i] = __builtin_nontemporal_load(src + (size_t)((t) * 64 + i) * (size_t)(Nsrc >> 2)); __builtin_amdgcn_sched_barrier(0); } while (0)
#define TL_EMIT(v, t) do { _Pragma("unroll") for (int e = 0; e < 4; ++e) { v4u o0, o1; \
        o0.x = pk2w(v[0][e], v[1][e]); o0.y = pk2w(v[2][e], v[3][e]); o0.z = pk2w(v[4][e], v[5][e]); o0.w = pk2w(v[6][e], v[7][e]); \
        o1.x = pk2w(v[8][e], v[9][e]); o1.y = pk2w(v[10][e], v[11][e]); o1.z = pk2w(v[12][e], v[13][e]); o1.w = pk2w(v[14][e], v[15][e]); \
        LAS v4u* w_ = (LAS v4u*)(scr + (4 * q + e) * 144 + 32 * h); w_[0] = o0; w_[1] = o1; } \
        LDS_WAIT(); asm volatile("" ::: "memory"); \
        _Pragma("unroll") for (int j = 0; j < 8; ++j) { const int n = (lane >> 3) + 8 * j; const v4u o = *(const LAS v4u*)(scr + n * 144 + 16 * (lane & 7)); \
            GAS v4u* d = (GAS v4u*)(WT + (size_t)(r0 + n) * K + k0 + (t) * 64 + 8 * (lane & 7)); if (NTS) __builtin_nontemporal_store(o, d); else *d = o; } \
        LDS_WAIT(); asm volatile("" ::: "memory"); } while (0)
template <int NT, bool NTS> __device__ __forceinline__ void tr_lds(const float* W, int Nsrc, int c0, bf16* WT, int K, int r0, int k0, LAS unsigned char* scr, int lane) {
    const int q = lane & 15, h = lane >> 4;
    const GAS f32x4* src = (const GAS f32x4*)(W + (size_t)(k0 + 16 * h) * Nsrc + c0 + 4 * q);
    f32x4 va[16], vb[16]; TL_LOAD(va, 0);
#pragma unroll
    for (int t = 0; t < NT; t += 2) { if (t + 1 < NT) TL_LOAD(vb, t + 1); TL_EMIT(va, t); if (t + 1 < NT) { if (t + 2 < NT) TL_LOAD(va, t + 2); TL_EMIT(vb, t + 1); } }
}
#undef TL_LOAD
#undef TL_EMIT
__device__ __forceinline__ unsigned q8pack(f32x4 v) {
    unsigned w = 0u;
    w = __builtin_amdgcn_cvt_pk_u8_f32(__builtin_rintf(v.x + 128.0f), 0, w); w = __builtin_amdgcn_cvt_pk_u8_f32(__builtin_rintf(v.y + 128.0f), 1, w);
    w = __builtin_amdgcn_cvt_pk_u8_f32(__builtin_rintf(v.z + 128.0f), 2, w); w = __builtin_amdgcn_cvt_pk_u8_f32(__builtin_rintf(v.w + 128.0f), 3, w);
    return w ^ 0x80808080u;
}
__device__ __forceinline__ void rms_row_to_bf16(const float* xrow, const float* g, bf16* orow, signed char* q8row, float* q8scale, int lane) {
    const GAS f32x4* xr = (const GAS f32x4*)xrow + lane; const GAS f32x4* gr = (const GAS f32x4*)g + lane;
    f32x4 v[16]; float s = 0.f;
#pragma unroll
    for (int j = 0; j < 16; ++j) { v[j] = xr[64 * j]; s += (v[j].x * v[j].x + v[j].y * v[j].y) + (v[j].z * v[j].z + v[j].w * v[j].w); }
    const float rstd = 1.0f / sqrtf(wave_sum(s) * (1.0f / DM) + EPS);
    GAS v2u* o8 = (GAS v2u*)orow + lane; float amax = 0.f;
#pragma unroll
    for (int j = 0; j < 16; ++j) { const f32x4 gv = gr[64 * j]; v[j] = v[j] * rstd * gv; v2u o; o.x = pk2(v[j].x, v[j].y); o.y = pk2(v[j].z, v[j].w); o8[64 * j] = o;
        amax = fmaxf(amax, fmaxf(fmaxf(fabsf(v[j].x), fabsf(v[j].y)), fmaxf(fabsf(v[j].z), fabsf(v[j].w)))); }
    if (q8row) {
#pragma unroll
        for (int o = 1; o < 64; o <<= 1) amax = fmaxf(amax, __shfl_xor(amax, o));
        const float qs = amax > 0.f ? 127.0f / amax : 0.f;
        if (lane == 0) *q8scale = amax * (1.0f / 127.0f);
        GAS unsigned* q4 = (GAS unsigned*)q8row + lane;
#pragma unroll
        for (int j = 0; j < 16; ++j) q4[64 * j] = q8pack(v[j] * qs);
    }
}

__device__ __forceinline__ void q8_strip(const float* W, int Nsrc, int c0, signed char* WT8, float* SB, int r0, LAS unsigned char* lds, int wave, int lane) {
    LAS float* red = (LAS float*)(lds + 12288); LAS unsigned* scr = (LAS unsigned*)(lds + wave * 16384);
    const float* src = W + (size_t)(wave * 512) * Nsrc + c0 + lane;
    float amax = 0.f;
    for (int t = 0; t < 8; ++t) { float v[64];
#pragma unroll
        for (int i = 0; i < 64; ++i) v[i] = src[(size_t)(t * 64 + i) * Nsrc];
#pragma unroll
        for (int i = 0; i < 64; ++i) amax = fmaxf(amax, fabsf(v[i])); }
    red[wave * 64 + lane] = amax;
    __syncthreads();
    float cmax = 0.f;
#pragma unroll
    for (int w = 0; w < 8; ++w) cmax = fmaxf(cmax, red[w * 64 + lane]);
    const float qs = cmax > 0.f ? 127.0f / cmax : 0.f;
    if (wave == 0) SB[r0 + lane] = cmax * (1.0f / 127.0f);
    for (int t = 0; t < 8; ++t) { float v[64];
#pragma unroll
        for (int i = 0; i < 64; ++i) v[i] = src[(size_t)(t * 64 + i) * Nsrc];
#pragma unroll
        for (int i = 0; i < 16; ++i) scr[i * 66 + lane] = q8pack((f32x4){v[4 * i] * qs, v[4 * i + 1] * qs, v[4 * i + 2] * qs, v[4 * i + 3] * qs});
        LDS_WAIT(); asm volatile("" ::: "memory");
        const int c = lane & 3;
#pragma unroll
        for (int jj = 0; jj < 4; ++jj) { const int n = (lane >> 2) + 16 * jj; const LAS unsigned* sq = scr + (4 * c) * 66 + n;
            v4u o; o.x = sq[0]; o.y = sq[66]; o.z = sq[132]; o.w = sq[198];
            *(GAS v4u*)(WT8 + (size_t)(r0 + n) * 4096 + wave * 512 + t * 64 + 16 * c) = o; }
        LDS_WAIT(); asm volatile("" ::: "memory"); }
    __syncthreads();
}
#define TR_LOAD(v, t) do { _Pragma("unroll") for (int i = 0; i < 16; ++i) v[i] = __builtin_nontemporal_load(src + (size_t)((t) * 64 + i) * (size_t)(Nsrc >> 2)); __builtin_amdgcn_sched_barrier(0); } while (0)
#define TR_EMIT_BF(v, t) do { _Pragma("unroll") for (int e = 0; e < 4; ++e) { v4u o0, o1; \
        o0.x = pk2w(v[0][e], v[1][e]); o0.y = pk2w(v[2][e], v[3][e]); o0.z = pk2w(v[4][e], v[5][e]); o0.w = pk2w(v[6][e], v[7][e]); \
        o1.x = pk2w(v[8][e], v[9][e]); o1.y = pk2w(v[10][e], v[11][e]); o1.z = pk2w(v[12][e], v[13][e]); o1.w = pk2w(v[14][e], v[15][e]); \
        GAS v4u* d = (GAS v4u*)(dst + (size_t)e * K + (t) * 64); __builtin_nontemporal_store(o0, d); __builtin_nontemporal_store(o1, d + 1); } } while (0)
#define TR_EMIT_I8(v, t) do { _Pragma("unroll") for (int e = 0; e < 4; ++e) { const float sc = qv[e]; v4u o; \
        o.x = q8pack((f32x4){v[0][e] * sc, v[1][e] * sc, v[2][e] * sc, v[3][e] * sc}); o.y = q8pack((f32x4){v[4][e] * sc, v[5][e] * sc, v[6][e] * sc, v[7][e] * sc}); \
        o.z = q8pack((f32x4){v[8][e] * sc, v[9][e] * sc, v[10][e] * sc, v[11][e] * sc}); o.w = q8pack((f32x4){v[12][e] * sc, v[13][e] * sc, v[14][e] * sc, v[15][e] * sc}); \
        { GAS v4u* d_ = (GAS v4u*)(dst + (size_t)e * 4096 + (t) * 64); if (MK_NT_COPY) __builtin_nontemporal_store(o, d_); else *d_ = o; } } } while (0)
#define TR_PIPE(EMIT) do { f32x4 va[16], vb[16]; TR_LOAD(va, 0); \
        _Pragma("unroll") for (int t = 0; t < NT; t += 2) { if (t + 1 < NT) TR_LOAD(vb, t + 1); EMIT(va, t); if (t + 1 < NT) { if (t + 2 < NT) TR_LOAD(va, t + 2); EMIT(vb, t + 1); } } } while (0)
#define TR_PIPE3(EMIT) do { f32x4 va[16], vb[16], vc[16]; TR_LOAD(va, 0); if (1 < NT) TR_LOAD(vb, 1); \
        _Pragma("unroll") for (int t = 0; t < NT; t += 3) { if (t + 2 < NT) TR_LOAD(vc, t + 2); EMIT(va, t); \
            if (t + 1 < NT) { if (t + 3 < NT) TR_LOAD(va, t + 3); EMIT(vb, t + 1); } \
            if (t + 2 < NT) { if (t + 4 < NT) TR_LOAD(vb, t + 4); EMIT(vc, t + 2); } } } while (0)
template <int NT> __device__ __forceinline__ void tr_run(const float* W, int Nsrc, int c0, bf16* WT, int K, int r0, int k0, int lane) {
    const int q = lane & 15, h = lane >> 4;
    const GAS f32x4* src = (const GAS f32x4*)(W + (size_t)(k0 + 16 * h) * Nsrc + c0 + 4 * q);
    bf16* dst = WT + (size_t)(r0 + 4 * q) * K + k0 + 16 * h;
    TR_PIPE(TR_EMIT_BF);
}
template <int NT> __device__ __forceinline__ void q8_run(const float* W, int Nsrc, int c0, signed char* WT8, int r0, int k0, float qs, int lane) {
    const int q = lane & 15, h = lane >> 4;
    f32x4 qv; qv.x = __shfl(qs, 4 * q); qv.y = __shfl(qs, 4 * q + 1); qv.z = __shfl(qs, 4 * q + 2); qv.w = __shfl(qs, 4 * q + 3);
    const GAS f32x4* src = (const GAS f32x4*)(W + (size_t)(k0 + 16 * h) * Nsrc + c0 + 4 * q);
    signed char* dst = WT8 + (size_t)(r0 + 4 * q) * 4096 + k0 + 16 * h;
    TR_PIPE3(TR_EMIT_I8);
}
struct Args { const float* in[27]; float* out; unsigned char* ws; int ph_lo, ph_hi; };
__device__ __forceinline__ const float* in_ptr(int i) {
    const __attribute__((address_space(4))) char* ka = (const __attribute__((address_space(4))) char*)__builtin_amdgcn_kernarg_segment_ptr();
    asm volatile("" : "+s"(ka));
    return *(const float* const __attribute__((address_space(4)))*)(ka + 8 * i);
}

typedef float f32x16 __attribute__((ext_vector_type(16)));
__device__ __forceinline__ int ssm_off(int j, int q) { return j * 528 + q * 4; }
template <bool PROMPT>
__device__ __forceinline__ void ssm_tile(LAS unsigned char* wb, LAS float* tot, const bf16* U, bf16* YS, const unsigned char* FRg, const float* LB, const float* SMETA,
                                         const float* st_re, const float* st_im, float* out, int g, int bq, int rowbase, int wave, int lane) {
    const int j = lane & 31, h2 = lane >> 5;
    const __amdgpu_buffer_rsrc_t rsF = __builtin_amdgcn_make_buffer_rsrc((void*)FRg, (short)0, NFRAG * 1024, 0x00020000);
    const __amdgpu_buffer_rsrc_t rsU = __builtin_amdgcn_make_buffer_rsrc((void*)(U + (size_t)rowbase * SSMW + g * 16), (short)0, 256 * SSMW * 2, 0x00020000);
    const unsigned voffF = (unsigned)lane * 16u, voffU = (unsigned)(8 * j * SSMW + 8 * h2) * 2u;
#define SSM_LDF(f) __builtin_bit_cast(bf16x8, __builtin_amdgcn_raw_buffer_load_b128(rsF, voffF, (f) * 1024, 0))
    bf16x8 X[8], WA[16], WB[16];
#pragma unroll
    for (int ks = 0; ks < 8; ++ks) X[ks] = __builtin_bit_cast(bf16x8, __builtin_amdgcn_raw_buffer_load_b128(rsU, voffU, ks * SSMW * 2, 0));
#pragma unroll
    for (int f = 0; f < 16; ++f) WA[f] = SSM_LDF(f);
    __builtin_amdgcn_sched_barrier(0);
#pragma unroll
    for (int f = 0; f < 16; ++f) WB[f] = SSM_LDF(16 + f);
    __builtin_amdgcn_sched_barrier(0);
#pragma unroll
    for (int qb = 0; qb < 4; ++qb) { f32x16 acc = {};
#pragma unroll
        for (int ks = 0; ks < 8; ++ks) acc = __builtin_amdgcn_mfma_f32_32x32x16_bf16(qb < 2 ? WA[qb * 8 + ks] : WB[(qb - 2) * 8 + ks], X[ks], acc, 0, 0, 0);
#pragma unroll
        for (int c4 = 0; c4 < 4; ++c4) *(LAS f32x4*)(wb + ssm_off(j, 32 * qb + 8 * c4 + 4 * h2)) = (f32x4){acc[4 * c4], acc[4 * c4 + 1], acc[4 * c4 + 2], acc[4 * c4 + 3]};
        __builtin_amdgcn_sched_barrier(0); }
    bf16x8 A0[10];
#pragma unroll
    for (int f = 0; f < 2; ++f) A0[f] = SSM_LDF(32 + f);
#pragma unroll
    for (int f = 0; f < 8; ++f) A0[2 + f] = SSM_LDF(52 + f);
    __builtin_amdgcn_sched_barrier(0);
    LDS_WAIT();
    const int gp = g * 64 + lane;
    float fre[32], fim[32];
#pragma unroll
    for (int jj = 0; jj < 32; ++jj) { fre[jj] = *(LAS float*)(wb + ssm_off(jj, lane)); fim[jj] = *(LAS float*)(wb + ssm_off(jj, 64 + lane)); }
    const float a1r = LB[2 * 8192 + gp], a1i = LB[3 * 8192 + gp];
    if (PROMPT) {
        const float a32r = LB[4 * 8192 + gp], a32i = LB[5 * 8192 + gp];
        float sr = SMETA[gp], si = SMETA[8192 + gp];
        float tr = 0.f, ti = 0.f;
#pragma unroll
        for (int jj = 0; jj < 32; ++jj) { const float nr = a1r * tr - a1i * ti + fre[jj], ni = a1r * ti + a1i * tr + fim[jj]; tr = nr; ti = ni; }
        tot[wave * 128 + lane] = tr; tot[wave * 128 + 64 + lane] = ti;
        __syncthreads();
        for (int w2 = 0; w2 < wave; ++w2) { const float xr = tot[w2 * 128 + lane], xi = tot[w2 * 128 + 64 + lane]; const float nr = a32r * sr - a32i * si + xr, ni = a32r * si + a32i * sr + xi; sr = nr; si = ni; }
        if (wave == 7) { out[OUT_PRE + (size_t)(bq * NG + g) * NST + lane] = a32r * sr - a32i * si + tr; out[OUT_PIM + (size_t)(bq * NG + g) * NST + lane] = a32r * si + a32i * sr + ti; }
#pragma unroll
        for (int jj = 0; jj < 32; ++jj) { *(LAS float*)(wb + ssm_off(jj, lane)) = sr; *(LAS float*)(wb + ssm_off(jj, 64 + lane)) = si;
            const float nr = a1r * sr - a1i * si + fre[jj], ni = a1r * si + a1i * sr + fim[jj]; sr = nr; si = ni; }
    } else {
#pragma unroll
        for (int j0 = 0; j0 < 32; j0 += 8) { float s0r[8], s0i[8];
#pragma unroll
            for (int jj = 0; jj < 8; ++jj) { const size_t so = ((size_t)(bq + j0 + jj) * NG + g) * NST + lane; s0r[jj] = st_re[so]; s0i[jj] = st_im[so]; }
            __builtin_amdgcn_sched_barrier(0);
#pragma unroll
            for (int jj = 0; jj < 8; ++jj) { const size_t so = ((size_t)(bq + j0 + jj) * NG + g) * NST + lane; const float sr = s0r[jj], si = s0i[jj];
                *(LAS float*)(wb + ssm_off(j0 + jj, lane)) = sr; *(LAS float*)(wb + ssm_off(j0 + jj, 64 + lane)) = si;
                out[OUT_SRE + so] = a1r * sr - a1i * si + fre[j0 + jj]; out[OUT_SIM + so] = a1r * si + a1i * sr + fim[j0 + jj]; } }
    }
    LDS_WAIT();
    bf16x8 S[8];
#pragma unroll
    for (int ks = 0; ks < 8; ++ks) { const f32x4 v0 = *(LAS f32x4*)(wb + ssm_off(j, 16 * ks + 8 * h2)), v1 = *(LAS f32x4*)(wb + ssm_off(j, 16 * ks + 8 * h2 + 4));
        S[ks] = __builtin_bit_cast(bf16x8, pg8::pack8(v0, v1)); }
#define SSM_OUT(rb, acc) do { _Pragma("unroll") for (int c4 = 0; c4 < 4; ++c4) { const int t = 2 * (rb) + (c4 >> 1), h0 = 8 * (c4 & 1) + 4 * h2; \
        v2u o; o.x = pg8::cvt_pk_bf16(gelu_tanh(acc[4 * c4]), gelu_tanh(acc[4 * c4 + 1])); o.y = pg8::cvt_pk_bf16(gelu_tanh(acc[4 * c4 + 2]), gelu_tanh(acc[4 * c4 + 3])); \
        *(GAS v2u*)(YS + (size_t)(rowbase + 8 * j + t) * SSMW + g * 16 + h0) = o; } } while (0)
    __builtin_amdgcn_sched_barrier(0);
    { bf16x8 A1[12];
#pragma unroll
      for (int f = 0; f < 4; ++f) A1[f] = SSM_LDF(34 + f);
#pragma unroll
      for (int f = 0; f < 8; ++f) A1[4 + f] = SSM_LDF(60 + f);
      __builtin_amdgcn_sched_barrier(0);
      f32x16 acc = {};
#pragma unroll
      for (int ks = 0; ks < 2; ++ks) acc = __builtin_amdgcn_mfma_f32_32x32x16_bf16(A0[ks], X[ks], acc, 0, 0, 0);
#pragma unroll
      for (int ks = 0; ks < 8; ++ks) acc = __builtin_amdgcn_mfma_f32_32x32x16_bf16(A0[2 + ks], S[ks], acc, 0, 0, 0);
      __builtin_amdgcn_sched_barrier(0);
      bf16x8 A2[14];
#pragma unroll
      for (int f = 0; f < 6; ++f) A2[f] = SSM_LDF(38 + f);
#pragma unroll
      for (int f = 0; f < 8; ++f) A2[6 + f] = SSM_LDF(68 + f);
      __builtin_amdgcn_sched_barrier(0);
      SSM_OUT(0, acc);
      __builtin_amdgcn_sched_barrier(0);
      f32x16 acc1 = {};
#pragma unroll
      for (int ks = 0; ks < 4; ++ks) acc1 = __builtin_amdgcn_mfma_f32_32x32x16_bf16(A1[ks], X[ks], acc1, 0, 0, 0);
#pragma unroll
      for (int ks = 0; ks < 8; ++ks) acc1 = __builtin_amdgcn_mfma_f32_32x32x16_bf16(A1[4 + ks], S[ks], acc1, 0, 0, 0);
      __builtin_amdgcn_sched_barrier(0);
      bf16x8 A3[16];
#pragma unroll
      for (int f = 0; f < 8; ++f) A3[f] = SSM_LDF(44 + f);
#pragma unroll
      for (int f = 0; f < 8; ++f) A3[8 + f] = SSM_LDF(76 + f);
      __builtin_amdgcn_sched_barrier(0);
      SSM_OUT(1, acc1);
      __builtin_amdgcn_sched_barrier(0);
      f32x16 acc2 = {};
#pragma unroll
      for (int ks = 0; ks < 6; ++ks) acc2 = __builtin_amdgcn_mfma_f32_32x32x16_bf16(A2[ks], X[ks], acc2, 0, 0, 0);
#pragma unroll
      for (int ks = 0; ks < 8; ++ks) acc2 = __builtin_amdgcn_mfma_f32_32x32x16_bf16(A2[6 + ks], S[ks], acc2, 0, 0, 0);
      SSM_OUT(2, acc2);
      __builtin_amdgcn_sched_barrier(0);
      f32x16 acc3 = {};
#pragma unroll
      for (int ks = 0; ks < 8; ++ks) acc3 = __builtin_amdgcn_mfma_f32_32x32x16_bf16(A3[ks], X[ks], acc3, 0, 0, 0);
#pragma unroll
      for (int ks = 0; ks < 8; ++ks) acc3 = __builtin_amdgcn_mfma_f32_32x32x16_bf16(A3[8 + ks], S[ks], acc3, 0, 0, 0);
      SSM_OUT(3, acc3); }
#undef SSM_OUT
#undef SSM_LDF
}

__global__ void __launch_bounds__(NWAVES * 64, 2) fwd(Args args) {
    extern __shared__ __attribute__((aligned(16))) unsigned char lds_raw[];
    LAS unsigned char* lds = (LAS unsigned char*)lds_raw;
    volatile LAS unsigned* MISC = (volatile LAS unsigned*)(lds + MISC_OFF);
    const int tid = threadIdx.x, lane = tid & 63, wave = __builtin_amdgcn_readfirstlane(tid >> 6);
    const int G = gridDim.x; const int bx = blockIdx.x; const int vcu = (G % 8 == 0) ? (bx % 8) * (G / 8) + bx / 8 : bx;
    const int gw = vcu * NWAVES + wave, NGW = G * NWAVES;
    unsigned char* ws = args.ws;
    unsigned* ctl = (unsigned*)(ws + WS_CTL);
    float* out = args.out;
    float* LB = (float*)(ws + WS_LB); float* BB = (float*)(ws + WS_BB); float* PM = (float*)(ws + WS_PM); bf16* HNM = (bf16*)(ws + WS_HNM);
    float* SMETA = (float*)(ws + WS_SMETA);
    bf16* WT_IN = (bf16*)(ws + WS_WIN); bf16* WT_GLU = (bf16*)(ws + WS_WGLU); bf16* WT_CO = (bf16*)(ws + WS_WCO); bf16* WT_O = (bf16*)(ws + WS_WO); bf16* WT_UP = (bf16*)(ws + WS_WUP); bf16* WT_DN = (bf16*)(ws + WS_WDN);
    bf16* HN = (bf16*)(ws + WS_R0); bf16* YS = (bf16*)(ws + WS_R0); bf16* YC = (bf16*)(ws + WS_R0 + A36); bf16* HF = (bf16*)(ws + WS_R0);
    bf16* U = (bf16*)(ws + WS_R1); bf16* Z = (bf16*)(ws + WS_R1 + A36); bf16* M1 = (bf16*)(ws + WS_R6 + A72);
    bf16* CB = (bf16*)(ws + WS_R2); bf16* SGA = (bf16*)(ws + WS_R3); bf16* SGB = (bf16*)(ws + WS_R4); bf16* MG = (bf16*)(ws + WS_R5);
    signed char* HN8 = (signed char*)(ws + WS_R5); signed char* WT_IN8 = (signed char*)(ws + WS_WIN + (size_t)64 * MiB); float* SAH = (float*)(ws + WS_SS1 + 131072); float* SBIN = (float*)(ws + WS_SS2 + 131072); signed char* HF8 = (signed char*)(ws + WS_R0); signed char* WT_UP8 = (signed char*)(ws + WS_WUP); float* SA = (float*)(ws + WS_SS1 + 65536); float* SB = (float*)(ws + WS_SS2); float* AMX = (float*)(ws + WS_R6 + A72);       bf16* OB = (bf16*)(ws + WS_R6); bf16* FB = (bf16*)(ws + WS_R6 + A72); bf16* XT = (bf16*)(ws + WS_WIN);   float* RS1 = (float*)(ws + WS_SS1); bf16* HB = (bf16*)(ws + WS_H);

    for (int u = tid; u < 64; u += NWAVES * 64) MISC[u] = 0u;
    __syncthreads();
    XcdBarrier bar; bar.bar = ctl + CW_BAR; bar.x = 0; bar.st = nullptr;
    if (N_LAUNCHES != N_PHASES) bar = xcd_barrier_post(ctl + CW_BAR, MISC + 8);
#define GRID_BAR() do { if (N_LAUNCHES != N_PHASES) xcd_barrier(bar); } while (0)
    const int lo = args.ph_lo, hi = args.ph_hi;
#define IN(k) (lo <= (k) && (k) < hi)
#define BOTH(k) (IN(k) && IN((k) + 1))

    if (IN(0)) {
        const float* x_prompt = in_ptr(0); const float* x_sample = in_ptr(1); const float* meta = in_ptr(5); const float* g_pre_mix = in_ptr(6); const float* w_in = in_ptr(7);
        const float* lam_re = in_ptr(8); const float* lam_im = in_ptr(9); const float* log_dt = in_ptr(10); const float* b_re = in_ptr(11); const float* b_im = in_ptr(12);
        const float* c_re = in_ptr(13); const float* c_im = in_ptr(14); const float* ssm_d = in_ptr(15); const float* w_glu_v = in_ptr(16); const float* w_glu_g = in_ptr(17);
        const float* w_conv_out = in_ptr(19); const float* w_o = in_ptr(20); const float* w_ffn_gate = in_ptr(23); const float* w_ffn_up = in_ptr(24); const float* w_ffn_down = in_ptr(25);
        for (int g = bx; g < NG; g += G) {
            LAS float* LPR = (LAS float*)(lds + RING_OFF); LAS float* LPI = LPR + 9 * 64; LAS float* BR = LPI + 9 * 64; LAS float* BI = BR + 1024;
            LAS float* CR = BI + 1024; LAS float* CI = CR + 1024; LAS float* MT = CI + 1024; LAS float* DD = MT + 2048;
            { const double dt = exp((double)log_dt[g]);
              for (int e = tid; e < 10 * 64; e += NWAVES * 64) {
                const int p = e & 63, dsel = e >> 6, idx = g * 64 + p; const double dd = dsel < 9 ? (double)dsel : 256.0;
                const double a = (double)lam_re[idx] * dt * dd, b = (double)lam_im[idx] * dt * dd, ea = exp(a); const float vr = (float)(ea * cos(b)), vi = (float)(ea * sin(b));
                if (dsel < 9) { LPR[dsel * 64 + p] = vr; LPI[dsel * 64 + p] = vi; }
                if (dsel == 1) { LB[idx] = vr; LB[8192 + idx] = vi; } else if (dsel == 8) { LB[2 * 8192 + idx] = vr; LB[3 * 8192 + idx] = vi; } else if (dsel == 9) { LB[4 * 8192 + idx] = vr; LB[5 * 8192 + idx] = vi; } }
              if (tid >= 128 && tid < 192) {
                const int p = tid - 128, idx = g * 64 + p; const double lr = (double)lam_re[idx], li = (double)lam_im[idx];
                const double a = lr * dt, b = li * dt, ea = exp(a), sb = sin(b), cb = cos(b);
                const double sh = sin(0.5 * b), nr = expm1(a) * cb - 2.0 * sh * sh, ni = ea * sb;
                const double inv = 1.0 / (lr * lr + li * li), qr = (nr * lr + ni * li) * inv, qi = (ni * lr - nr * li) * inv;
                for (int h = 0; h < 16; ++h) { const double br = (double)b_re[idx * 16 + h], bi = (double)b_im[idx * 16 + h];
                    const float vr = (float)(qr * br - qi * bi), vi = (float)(qr * bi + qi * br);
                    BB[idx * 16 + h] = vr; BB[131072 + idx * 16 + h] = vi; BR[p * 16 + h] = vr; BI[p * 16 + h] = vi; } } }
            for (int i = tid; i < 1024; i += NWAVES * 64) { CR[i] = c_re[g * 1024 + i]; CI[i] = c_im[g * 1024 + i]; }
            if (tid < 16) DD[tid] = ssm_d[g * 16 + tid];
            __syncthreads();
            for (int e = tid; e < 2048; e += NWAVES * 64) { const int d = e >> 8, h = (e >> 4) & 15, hp = e & 15; float sacc = 0.f;
                for (int p = 0; p < 64; ++p) { const float cr = CR[h * 64 + p], ci = CI[h * 64 + p], lr = LPR[d * 64 + p], li = LPI[d * 64 + p];
                    const float tr = cr * lr - ci * li, ti = cr * li + ci * lr; sacc += tr * BR[p * 16 + hp] - ti * BI[p * 16 + hp]; }
                MT[e] = sacc; }
            __syncthreads();
            unsigned char* FRg = ws + WS_FR + (size_t)g * NFRAG * 1024;
            for (int pr = tid; pr < NFRAG * 64; pr += NWAVES * 64) {
                const int f = pr >> 6, l = pr & 63, row = l & 31, kb = 8 * (l >> 5); float v[8];
                if (f < 32) { const int qb = f >> 3, ks = f & 7, q = 32 * qb + row, p = q & 63;
#pragma unroll
                    for (int i = 0; i < 8; ++i) { const float lr = LPR[(7 - ks) * 64 + p], li = LPI[(7 - ks) * 64 + p], br = BR[p * 16 + kb + i], bi = BI[p * 16 + kb + i];
                        v[i] = (q < 64) ? (lr * br - li * bi) : (lr * bi + li * br); }
                } else if (f < 52) { const int ft = f - 32, rb = ft < 2 ? 0 : (ft < 6 ? 1 : (ft < 12 ? 2 : 3)), ks = ft - rb * (rb + 1), t = 2 * rb + (row >> 4), h = row & 15;
#pragma unroll
                    for (int i = 0; i < 8; ++i) { const int hp = kb + i; float x = 0.f; if (t >= ks) { x = MT[((t - ks) << 8) + (h << 4) + hp]; if (t == ks && h == hp) x += DD[h]; } v[i] = x; }
                } else { const int fg = f - 52, rb = fg >> 3, ks = fg & 7, t = 2 * rb + (row >> 4), h = row & 15;
#pragma unroll
                    for (int i = 0; i < 8; ++i) { const int q = 16 * ks + kb + i, p = q & 63; const float cr = CR[h * 64 + p], ci = CI[h * 64 + p], lr = LPR[(t + 1) * 64 + p], li = LPI[(t + 1) * 64 + p];
                        v[i] = (q < 64) ? (cr * lr - ci * li) : -(cr * li + ci * lr); }
                }
                v4u o; o.x = pk2(v[0], v[1]); o.y = pk2(v[2], v[3]); o.z = pk2(v[4], v[5]); o.w = pk2(v[6], v[7]);
                *(GAS v4u*)(FRg + (size_t)pr * 16) = o;
            }
            __syncthreads();
        }
        LAS unsigned* scr = (LAS unsigned*)(lds + RING_OFF + wave * 16384);
        if (bx >= G - NG) { const int st = bx - (G - NG);
            q8_strip(w_in, INCOLS, 8192 + 64 * st, WT_IN8, SBIN, 64 * st, lds + RING_OFF, wave, lane); }
        constexpr int I_IN = (DM / 64) * (8192 / 64);
        for (int it = gw; it < I_IN; it += NGW) {
            const int nblk = 8192 / 64, kb = it / nblk, nb = it % nblk, r0 = nb * 64; int c0;
            if (r0 < 2048) c0 = r0;
            else if (r0 < 6144) { const int q = r0 - 2048; c0 = (((q >> 7) & 1) ? 6144 : 2048) + 128 * (q >> 8) + (q & 127); }
            else if (r0 < 8192) c0 = 4096 + (r0 - 6144);
            else c0 = r0;
            p0_transpose_item(w_in, INCOLS, c0, WT_IN, DM, r0, kb * 64, scr, lane);
        }
        for (int it = gw; it < 2 * (DFF / 256) * (DM / 64); it += NGW) {
            const int kc = it / (2 * (DFF / 256)), sp = it % (2 * (DFF / 256)), sel = sp / (DFF / 256), c0 = (sp % (DFF / 256)) * 256 + 4 * lane;
            const GAS f32x4* src = (const GAS f32x4*)((sel ? w_ffn_up : w_ffn_gate) + (size_t)(kc * 64) * DFF + c0);
            f32x4 mx = (f32x4){0.f, 0.f, 0.f, 0.f};
#pragma unroll
            for (int t = 0; t < 4; ++t) { f32x4 v[16];
#pragma unroll
                for (int i = 0; i < 16; ++i) v[i] = __builtin_nontemporal_load(src + (size_t)(t * 16 + i) * (DFF / 4));
#pragma unroll
                for (int i = 0; i < 16; ++i) { mx.x = fmaxf(mx.x, fabsf(v[i].x)); mx.y = fmaxf(mx.y, fabsf(v[i].y)); mx.z = fmaxf(mx.z, fabsf(v[i].z)); mx.w = fmaxf(mx.w, fabsf(v[i].w)); } }
            *(GAS f32x4*)(AMX + (size_t)kc * (2 * DFF) + 256 * (c0 >> 7) + 128 * sel + (c0 & 127)) = mx; }
        for (int m = gw; m < M + NMETA; m += NGW) {
            const float* xr = m < MP ? x_prompt + (size_t)m * DM : (m < M ? x_sample + (size_t)(m - MP) * DM : meta + (size_t)(m - M) * DM);
            bf16* orow = m < M ? HN + (size_t)m * DM : HNM + (size_t)(m - M) * DM;
            rms_row_to_bf16(xr, g_pre_mix, orow, m < M ? HN8 + (size_t)m * DM : nullptr, SAH + (m < M ? m : 0), lane);
        }
        if (BOTH(0)) GRID_BAR();
    }

    if (IN(1)) {
      const int GG = G - NCONV;
      if (NCONV == 0 || bx >= GG) {
        const int cw0 = NCONV ? (bx - GG) * NWAVES + wave : gw, cwn = NCONV ? NCONV * NWAVES : NGW;
        const float* w_glu_v = in_ptr(16); const float* w_glu_g = in_ptr(17); const float* w_conv_out = in_ptr(19); const float* w_o = in_ptr(20);
        const float* w_ffn_gate = in_ptr(23); const float* w_ffn_up = in_ptr(24); const float* w_ffn_down = in_ptr(25);
#ifdef MK_PROBE_C2
        for (int rep = 0; rep < 2; ++rep) {
#endif
        constexpr int I_UP = (2 * DFF / 64) * (DM / 256), I_GLU = (SSMW / 256) * (2 * DM / 64), I_CO = (CONVW / 256) * (DM / 64), I_O = (DM / 256) * (DM / 64);
        constexpr int I_DN = (DFF / 128) * (DM / 64), NITEMS = I_UP + I_GLU + I_CO + I_O + I_DN;
        for (int it = cw0; it < NITEMS; it += cwn) {
            int r = it;
            if (r < I_UP) { const int ch = r / (2 * DFF / 64), st = r % (2 * DFF / 64), r0 = st * 64; float cmax = 0.f;
#pragma unroll
                for (int c = 0; c < DM / 64; ++c) cmax = fmaxf(cmax, AMX[c * (2 * DFF) + r0 + lane]);
                if (ch == 0) SB[r0 + lane] = cmax * (1.0f / 127.0f);
                q8_run<4>(((r0 >> 7) & 1) ? w_ffn_up : w_ffn_gate, DFF, 128 * (r0 >> 8) + (r0 & 127), WT_UP8, r0, ch * 256, cmax > 0.f ? 127.0f / cmax : 0.f, lane); continue; } r -= I_UP;
            if (r < I_GLU) { const int nblk = 2 * DM / 64, kb = r / nblk, nb = r % nblk, r0 = nb * 64; const int c0 = 128 * (r0 >> 8) + (r0 & 127);
                tr_lds<4, MK_NT_COPY != 0>(((r0 >> 7) & 1) ? w_glu_g : w_glu_v, DM, c0, WT_GLU, SSMW, r0, kb * 256, lds + RING_OFF + wave * 16384, lane); continue; } r -= I_GLU;
            if (r < I_CO) { const int nblk = DM / 64, kb = r / nblk, nb = r % nblk; tr_lds<4, MK_NT_COPY != 0>(w_conv_out, DM, nb * 64, WT_CO, CONVW, nb * 64, kb * 256, lds + RING_OFF + wave * 16384, lane); continue; } r -= I_CO;
            if (r < I_O) { const int nblk = DM / 64, kb = r / nblk, nb = r % nblk; tr_lds<4, MK_NT_COPY != 0>(w_o, DM, nb * 64, WT_O, DM, nb * 64, kb * 256, lds + RING_OFF + wave * 16384, lane); continue; } r -= I_O;
            { const int nblk = DM / 64, kb = r / nblk, nb = r % nblk; tr_lds<2, MK_NT_COPY != 0>(w_ffn_down, DM, nb * 64, WT_DN, DFF, nb * 64, kb * 128, lds + RING_OFF + wave * 16384, lane); }
        }
#ifdef MK_PROBE_C2
        }
#endif
      }
      if (NCONV == 0) __syncthreads();
      if (NCONV == 0 || bx < GG) {
        LAS float* red = (LAS float*)(lds + RING_OFF);
        for (int t = bx; t < NMETACOLS / 16; t += GG) {
            const int n0 = t * 16, kbase = wave * 512;
            const bf16* ap = HNM + (size_t)(lane & 15) * DM + kbase + 8 * (lane >> 4);
            const bf16* bp = WT_IN + (size_t)(n0 + (lane & 15)) * DM + kbase + 8 * (lane >> 4);
            f32x4 acc = (f32x4){0.f, 0.f, 0.f, 0.f};
#pragma unroll 4
            for (int k = 0; k < 512; k += 32) { const bf16x8 af = *(const GAS bf16x8*)(ap + k), bf = *(const GAS bf16x8*)(bp + k);
                acc = __builtin_amdgcn_mfma_f32_16x16x32_bf16(af, bf, acc, 0, 0, 0); }
#pragma unroll
            for (int r = 0; r < 4; ++r) red[(wave * 4 + r) * 64 + lane] = acc[r];
            __syncthreads();
            LAS float* pmt = red + 2048;
            if (tid < 256) { const int r = tid >> 6; float s = 0.f;
#pragma unroll
                for (int w = 0; w < 8; ++w) s += red[(w * 4 + r) * 64 + lane];
                PM[(size_t)(4 * (lane >> 4) + r) * NMETACOLS + n0 + (lane & 15)] = s; pmt[(4 * (lane >> 4) + r) * 16 + (lane & 15)] = s; }
            __syncthreads();
            if (t < NG && wave == 0) {
                const int gp = t * 64 + lane; const float lbr = LB[gp], lbi = LB[8192 + gp]; float bbr[16], bbi[16], sr = 0.f, si = 0.f;
#pragma unroll
                for (int h = 0; h < 16; ++h) { bbr[h] = BB[gp * 16 + h]; bbi[h] = BB[131072 + gp * 16 + h]; }
                for (int tau = 0; tau < NMETA; ++tau) { float br = 0.f, bi = 0.f;
#pragma unroll
                    for (int h = 0; h < 16; ++h) { const float uu = pmt[tau * 16 + h]; br = fmaf(bbr[h], uu, br); bi = fmaf(bbi[h], uu, bi); }
                    const float nr = lbr * sr - lbi * si + br, ni = lbr * si + lbi * sr + bi; sr = nr; si = ni; }
                SMETA[gp] = sr; SMETA[8192 + gp] = si;
            }
        }
        __syncthreads();
#ifdef MK_PROBE_G2
        for (int rep = 0; rep < 2; ++rep) {
#endif
        { pg8::Gemm g{(const bf16*)HN8, (const bf16*)WT_IN8, M, 8192, DM / 2}; typedef pg8::StaticOrderT<M, 8192, DM / 2> SO; SO S; S.init(GG, bx);
          pg8::EpiGateI8 E{SGA, SGB, SAH, SBIN};
          pg8::gemm_phase<pg8::EpiGateI8, SO, true, true, pg8::NoHook, true>(lds + RING_OFF, g, S, E); }
        { pg8::Gemm g{HN, WT_IN, M, 8192, DM}; typedef pg8::StaticOrderT<M, 8192, DM> SO; SO S; S.init(GG, NCONV ? bx : (bx + G / 2) % G);
          pg8::EpiProj E{U, Z, CB, SGA, SGB};
          pg8::gemm_phase<pg8::EpiProj, SO, true, true>(lds + RING_OFF, g, S, E); }
#ifdef MK_PROBE_G2
        }
#endif
      }
        if (BOTH(1)) GRID_BAR();
    }

    if (IN(2)) {
        const float* st_re = in_ptr(2); const float* st_im = in_ptr(3);
        {
            LAS unsigned char* wb = lds + RING_OFF + wave * SSM_WB; int par = 0;
            for (int it = bx; it < NBATCH * NG; it += G) {
                const int g = __builtin_amdgcn_readfirstlane(G == 256 ? 64 * ((bx >> 2) & 1) + 32 * (it >> 8) + (bx >> 3) : it >> 2), b = __builtin_amdgcn_readfirstlane(it & 3);
                ssm_tile<true>(wb, (LAS float*)(lds + TOT_OFF + par * 4096), U, YS, ws + WS_FR + (size_t)g * NFRAG * 1024, LB, SMETA, st_re, st_im, out, g, b, b * SEQ + 256 * wave, wave, lane);
                par ^= 1; }
            for (int it = bx; it < NG / 2; it += G) {
                const int g = __builtin_amdgcn_readfirstlane(2 * it + (wave >> 2)), tile = wave & 3;
                ssm_tile<false>(wb, (LAS float*)(lds + TOT_OFF), U, YS, ws + WS_FR + (size_t)g * NFRAG * 1024, LB, SMETA, st_re, st_im, out, g, 32 * tile, MP + 256 * tile, wave, lane); }
            if (bx >= NG / 2) {
                const float* st_cv = in_ptr(4); const float* conv_w = in_ptr(18);
            const int nthr = (G - NG / 2) * NWAVES * 64, t0 = ((bx - NG / 2) * NWAVES + wave) * 64 + lane;
            for (int it = t0; it < M * (CONVW / 8); it += nthr) {
                const int row = it >> 8, c = (it & 255) * 8;
                float z1[8], z2[8];
                const v4u z0w = *(const GAS v4u*)(Z + (size_t)row * CONVW + c), cbw = *(const GAS v4u*)(CB + (size_t)row * CONVW + c);
                int t; const float* sv1 = nullptr; const float* sv2 = nullptr; int m1 = -1, m2 = -1;
                if (row < MP) { t = row & (SEQ - 1); if (t < 1) m1 = 15; if (t < 2) m2 = 14 + t; }
                else { const int sI = row - MP, b = sI >> 3; t = sI & 7; if (t < 1) sv1 = st_cv + (size_t)(b * 2 + 1) * CONVW + c; if (t < 2) sv2 = st_cv + (size_t)(b * 2 + t) * CONVW + c; }
                if (t >= 1) { const v4u w = *(const GAS v4u*)(Z + (size_t)(row - 1) * CONVW + c); z1[0] = bflo(w.x); z1[1] = bfhi(w.x); z1[2] = bflo(w.y); z1[3] = bfhi(w.y); z1[4] = bflo(w.z); z1[5] = bfhi(w.z); z1[6] = bflo(w.w); z1[7] = bfhi(w.w); }
                else if (sv1) {
#pragma unroll
                    for (int e = 0; e < 8; ++e) z1[e] = sv1[e]; }
                else {
#pragma unroll
                    for (int e = 0; e < 8; ++e) { const int cc = c + e, q = 2048 + (cc >> 7) * 256 + (cc & 127); z1[e] = PM[(size_t)m1 * NMETACOLS + q] * PM[(size_t)m1 * NMETACOLS + q + 128]; } }
                if (t >= 2) { const v4u w = *(const GAS v4u*)(Z + (size_t)(row - 2) * CONVW + c); z2[0] = bflo(w.x); z2[1] = bfhi(w.x); z2[2] = bflo(w.y); z2[3] = bfhi(w.y); z2[4] = bflo(w.z); z2[5] = bfhi(w.z); z2[6] = bflo(w.w); z2[7] = bfhi(w.w); }
                else if (sv2) {
#pragma unroll
                    for (int e = 0; e < 8; ++e) z2[e] = sv2[e]; }
                else {
#pragma unroll
                    for (int e = 0; e < 8; ++e) { const int cc = c + e, q = 2048 + (cc >> 7) * 256 + (cc & 127); z2[e] = PM[(size_t)m2 * NMETACOLS + q] * PM[(size_t)m2 * NMETACOLS + q + 128]; } }
                const float z0[8] = {bflo(z0w.x), bfhi(z0w.x), bflo(z0w.y), bfhi(z0w.y), bflo(z0w.z), bfhi(z0w.z), bflo(z0w.w), bfhi(z0w.w)};
                const float cbv[8] = {bflo(cbw.x), bfhi(cbw.x), bflo(cbw.y), bfhi(cbw.y), bflo(cbw.z), bfhi(cbw.z), bflo(cbw.w), bfhi(cbw.w)};
                float y[8];
#pragma unroll
                for (int e = 0; e < 8; ++e) y[e] = cbv[e] * (conv_w[c + e] * z2[e] + conv_w[CONVW + c + e] * z1[e] + conv_w[2 * CONVW + c + e] * z0[e]);
                v4u o; o.x = pk2(y[0], y[1]); o.y = pk2(y[2], y[3]); o.z = pk2(y[4], y[5]); o.w = pk2(y[6], y[7]);
                *(GAS v4u*)(YC + (size_t)row * CONVW + c) = o;
            }
            for (int it = t0; it < (NBATCH + DBATCH) * 2 * CONVW; it += nthr) {
                const int c = it & (CONVW - 1), k = (it >> 11) & 1, sq = it >> 12;
                if (sq < NBATCH) out[OUT_PCV + (size_t)(sq * 2 + k) * CONVW + c] = bf1(Z[(size_t)(sq * SEQ + SEQ - 2 + k) * CONVW + c]);
                else { const int b = sq - NBATCH; out[OUT_SCV + (size_t)(b * 2 + k) * CONVW + c] = bf1(Z[(size_t)(MP + b * DSEQ + DSEQ - 2 + k) * CONVW + c]); }
            }
            }
        }
        if (BOTH(2)) GRID_BAR();
    }

    if (IN(3)) {
        pg8::Gemm g{YS, WT_GLU, M, 2 * DM, SSMW}; typedef pg8::StaticOrderT<M, 2 * DM, SSMW> SO; SO S; S.init(G, bx);
        pg8::EpiGlu E{SGA, M1};
        pg8::gemm_phase<pg8::EpiGlu, SO, true, true>(lds + RING_OFF, g, S, E);
        if (BOTH(3)) GRID_BAR();
    }
    if (IN(4)) {
        pg8::Gemm g{YC, WT_CO, M, DM, CONVW}; typedef pg8::TailSplitOrderT<MP, M, DM, CONVW, 4> SO; SO S; S.init(G, bx);
        pg8::EpiConvOut E{SGB, M1, MG, XT, MP, MSMP};
        pg8::gemm_phase<pg8::EpiConvOut, SO, true, true>(lds + RING_OFF, g, S, E);
        if (BOTH(4)) GRID_BAR();
    }
    if (IN(5)) {
        for (int it = gw; it < 2 * MSMP; it += NGW) {
            const int r = it >> 1, cbase = (it & 1) * 2048; const size_t ro = (size_t)(MP + r) * DM + cbase;
            const GAS v4u* xp = (const GAS v4u*)(XT + (size_t)r * DM + cbase) + lane;
            const GAS v4u* m1 = (const GAS v4u*)(M1 + ro) + lane; const GAS v2u* sg = (const GAS v2u*)((const GAS unsigned char*)SGB + ro) + lane; GAS v4u* mg = (GAS v4u*)(MG + ro) + lane;
#pragma unroll
            for (int j = 0; j < 4; ++j) { f32x4 a0, a1; pg8::unpack8(xp[64 * j], a0, a1);
#pragma unroll
                for (int p = 1; p < 4; ++p) { f32x4 c0, c1; pg8::unpack8(xp[64 * j + (size_t)p * MSMP * DM / 8], c0, c1); a0 = a0 + c0; a1 = a1 + c1; }
                f32x4 b0, b1, s0, s1; pg8::unpack8(m1[64 * j], b0, b1); { const v2u w = sg[64 * j]; pg8::u32x2 w2; w2.x = w.x; w2.y = w.y; pg8::unpack8u(w2, s0, s1); }
                mg[64 * j] = pg8::pack8(b0 + s0 * a0, b1 + s1 * a1); }
        }
        if (BOTH(5)) GRID_BAR();
    }
    if (IN(6)) {
        pg8::Gemm g{MG, WT_O, M, DM, DM}; typedef pg8::TailSplitOrderT<MP, M, DM, DM, 4> SO; SO S; S.init(G, bx);
        pg8::EpiBf16Parts E{OB, XT, MP, MSMP};
        pg8::gemm_phase<pg8::EpiBf16Parts, SO, true, true>(lds + RING_OFF, g, S, E);
        if (BOTH(6)) GRID_BAR();
    }
    if (IN(7)) {
        const float* x_prompt = in_ptr(0); const float* x_sample = in_ptr(1); const float* g_post_mix = in_ptr(21); const float* g_pre_ffn = in_ptr(22);
        for (int m = gw; m < M; m += NGW) {
            const GAS f32x4* xr = (const GAS f32x4*)(m < MP ? x_prompt + (size_t)m * DM : x_sample + (size_t)(m - MP) * DM) + 2 * lane;
            const GAS f32x4* g1 = (const GAS f32x4*)g_post_mix + 2 * lane; const GAS f32x4* g2 = (const GAS f32x4*)g_pre_ffn + 2 * lane;
            GAS v4u* ob = (GAS v4u*)(OB + (size_t)m * DM) + lane;
            f32x4 v[8][2]; float s = 0.f;
            if (m < MP) {
#pragma unroll
                for (int j = 0; j < 8; ++j) pg8::unpack8(ob[64 * j], v[j][0], v[j][1]);
            } else {
                const GAS v4u* xp = (const GAS v4u*)(XT + (size_t)(m - MP) * DM) + lane;
#pragma unroll
                for (int j = 0; j < 8; ++j) { f32x4 a0, a1; pg8::unpack8(xp[64 * j], a0, a1);
#pragma unroll
                    for (int p = 1; p < 4; ++p) { f32x4 c0, c1; pg8::unpack8(xp[64 * j + (size_t)p * MSMP * DM / 8], c0, c1); a0 = a0 + c0; a1 = a1 + c1; }
                    pg8::unpack8(pg8::pack8(a0, a1), v[j][0], v[j][1]); }
            }
#pragma unroll
            for (int j = 0; j < 8; ++j)
#pragma unroll
                for (int q = 0; q < 2; ++q) s += (v[j][q].x * v[j][q].x + v[j][q].y * v[j][q].y) + (v[j][q].z * v[j][q].z + v[j][q].w * v[j][q].w);
            const float rstd = 1.0f / sqrtf(wave_sum(s) * (1.0f / DM) + EPS);
            s = 0.f;
#pragma unroll
            for (int j = 0; j < 8; ++j)
#pragma unroll
                for (int q = 0; q < 2; ++q) { v[j][q] = xr[128 * j + q] + v[j][q] * rstd * g1[128 * j + q]; s += (v[j][q].x * v[j][q].x + v[j][q].y * v[j][q].y) + (v[j][q].z * v[j][q].z + v[j][q].w * v[j][q].w); }
            const float rstd2 = 1.0f / sqrtf(wave_sum(s) * (1.0f / DM) + EPS);
#pragma unroll
            for (int j = 0; j < 8; ++j) ob[64 * j] = pg8::pack8(v[j][0], v[j][1]);
            float amax = 0.f;
#pragma unroll
            for (int j = 0; j < 8; ++j)
#pragma unroll
                for (int q = 0; q < 2; ++q) { v[j][q] = v[j][q] * rstd2 * g2[128 * j + q];
                    amax = fmaxf(amax, fmaxf(fmaxf(fabsf(v[j][q].x), fabsf(v[j][q].y)), fmaxf(fabsf(v[j][q].z), fabsf(v[j][q].w)))); }
#pragma unroll
            for (int o = 1; o < 64; o <<= 1) amax = fmaxf(amax, __shfl_xor(amax, o));
            const float qs = amax > 0.f ? 127.0f / amax : 0.f;
            if (lane == 0) SA[m] = amax * (1.0f / 127.0f);
            GAS v2u* o8 = (GAS v2u*)(HF8 + (size_t)m * DM) + lane;
#pragma unroll
            for (int j = 0; j < 8; ++j) { v2u o;
                o.x = q8pack(v[j][0] * qs); o.y = q8pack(v[j][1] * qs); o8[64 * j] = o; }
        }
        if (BOTH(7)) GRID_BAR();
    }
    if (IN(8)) {
#if MK_P7_TAIL
        pg8::Gemm g{(const bf16*)HF8, (const bf16*)WT_UP8, M, 2 * DFF, DM / 2}; typedef pg8::RoundsTailOrderT<M, 2 * DFF, DM / 2, 8, 256> SO; SO S; S.init(bx);
        pg8::EpiSwiGluI8 E{HB, (pg8::f32x4*)(ws + WS_R5), SA, SB};
        if (G == 256) pg8::gemm_phase<pg8::EpiSwiGluI8, SO, true, true, pg8::NoHook, true>(lds + RING_OFF, g, S, E);
        if (BOTH(8)) GRID_BAR();
#else
        pg8::Gemm g{HF, WT_UP, M, 2 * DFF, DM}; typedef pg8::StaticOrderT<M, 2 * DFF, DM> SO; SO S; S.init(G, bx);
        pg8::EpiSwiGlu E{HB, (pg8::f32x4*)(ws + WS_R5)};
        pg8::gemm_phase<pg8::EpiSwiGlu, SO, true, true>(lds + RING_OFF, g, S, E);
#endif
    }
#if defined(MK_PROBE_SAMETILE)
    if (IN(9)) {
        struct SameTile { int pm, pn; __device__ __forceinline__ long long next(int i) const { return i < 12 ? pg8::pack_unit(pm, pn, 0, 0, DM / 64) : -1ll; } __device__ __forceinline__ int max_units() const { return 12; } };
        pg8::Gemm g{HF, WT_UP, M, 2 * DFF, DM}; SameTile S{MK_PROBE_SAMETILE ? (bx & 31) : 0, MK_PROBE_SAMETILE ? (bx >> 5) : 0}; pg8::EpiSwiGlu E{HB, (pg8::f32x4*)(ws + WS_R5)};
        pg8::gemm_phase<pg8::EpiSwiGlu, SameTile, true, true>(lds + RING_OFF, g, S, E);
        GRID_BAR();
    }
#endif
    if (IN(9)) {
#if MK_P7_TAIL
        typedef pg8::RoundsTailOrderT<M, 2 * DFF, DM / 2, 8, 256> SO;
        for (int it = bx; it < SO::nTail * 8; it += G) {
            const int tu = it >> 3, ai = (it >> 2) & 1, m = it & 3; const pg8::Unit u = pg8::unpack_unit(SO::WO::map(SO::R * 256 + tu));
            const int wr = wave >> 2, wc = wave & 3, fr = lane & 15, fq = lane >> 4;
            const pg8::u32x4* sp = (const pg8::u32x4*)(ws + WS_R5) + (size_t)(tu * 8) * 16 * 512 + tid;
            pg8::f32x4 v[2][2];
#pragma unroll
            for (int bj = 0; bj < 2; ++bj) { pg8::unpack8(sp[((ai * 2 + bj) * 4 + m) * 512], v[bj][0], v[bj][1]);
#pragma unroll
                for (int p = 1; p < 8; ++p) { pg8::f32x4 c0, c1; pg8::unpack8(sp[((size_t)p * 16 + ((ai * 2 + bj) * 4 + m)) * 512], c0, c1); v[bj][0] = v[bj][0] + c0; v[bj][1] = v[bj][1] + c1; } }
            const int row = u.pm * 256 + wr * 64 + fr + ai * 128 + m * 16, cq = u.pn * 256 + wc * 32 + 8 * fq; const float sa = SA[row];
            const pg8::f32x4 g0 = v[0][0] * (*(const pg8::f32x4*)(SB + cq) * sa), g1 = v[0][1] * (*(const pg8::f32x4*)(SB + cq + 4) * sa);
            const pg8::f32x4 u0 = v[1][0] * (*(const pg8::f32x4*)(SB + cq + 128) * sa), u1 = v[1][1] * (*(const pg8::f32x4*)(SB + cq + 132) * sa);
            const size_t off = (size_t)row * DFF + u.pn * 128 + wc * 32 + 8 * fq;
            *(pg8::u32x4*)(HB + off) = pg8::pack8(g0 * pg8::sigm4(g0) * u0, g1 * pg8::sigm4(g1) * u1);
        }
#endif
        if (BOTH(9)) GRID_BAR();
    }
    if (IN(10)) {
        pg8::Gemm g{HB, WT_DN, M, DM, DFF}; typedef pg8::TailSplitOrderT<MP, M, DM, DFF, 4> SO; SO S; S.init(G, bx);
        pg8::EpiBf16Parts E{FB, XT, MP, MSMP};
        pg8::gemm_phase<pg8::EpiBf16Parts, SO, true, true>(lds + RING_OFF, g, S, E);
        if (BOTH(10)) GRID_BAR();
    }
    if (IN(11)) {
        const float* g_post_ffn = in_ptr(26);
        for (int m = gw; m < M; m += NGW) {
            const GAS f32x4* g3 = (const GAS f32x4*)g_post_ffn + 2 * lane;
            const GAS v4u* ob = (const GAS v4u*)(OB + (size_t)m * DM) + lane; const GAS v4u* fb = (const GAS v4u*)(FB + (size_t)m * DM) + lane;
            GAS f32x4* yo = (GAS f32x4*)(out + OUT_Y + (size_t)m * DM) + 2 * lane;
            f32x4 v[8][2]; float s = 0.f;
            if (m < MP) {
#pragma unroll
                for (int j = 0; j < 8; ++j) pg8::unpack8(fb[64 * j], v[j][0], v[j][1]);
            } else {
                const GAS v4u* xp = (const GAS v4u*)(XT + (size_t)(m - MP) * DM) + lane;
#pragma unroll
                for (int j = 0; j < 8; ++j) { f32x4 a0, a1; pg8::unpack8(xp[64 * j], a0, a1);
#pragma unroll
                    for (int p = 1; p < 4; ++p) { f32x4 c0, c1; pg8::unpack8(xp[64 * j + (size_t)p * MSMP * DM / 8], c0, c1); a0 = a0 + c0; a1 = a1 + c1; }
                    v[j][0] = a0; v[j][1] = a1; }
            }
#pragma unroll
            for (int j = 0; j < 8; ++j)
#pragma unroll
                for (int q = 0; q < 2; ++q) s += (v[j][q].x * v[j][q].x + v[j][q].y * v[j][q].y) + (v[j][q].z * v[j][q].z + v[j][q].w * v[j][q].w);
            const float rstd = 1.0f / sqrtf(wave_sum(s) * (1.0f / DM) + EPS);
#pragma unroll
            for (int j = 0; j < 8; ++j) { f32x4 o0, o1; pg8::unpack8(ob[64 * j], o0, o1);
                yo[128 * j] = o0 + v[j][0] * rstd * g3[128 * j];
                yo[128 * j + 1] = o1 + v[j][1] * rstd * g3[128 * j + 1]; }
        }
    }
#undef IN
#undef BOTH
#undef GRID_BAR
}

extern "C" void kernel_launch(void* const* d_in, const int* in_sizes, int n_in, void* d_out, int out_size, void* d_ws, size_t ws_size, hipStream_t stream) {
    static int grid = 0;
    if (grid == 0) {
        if (n_in != 27 || out_size != (int)OUT_END || ws_size < WS_END) { fprintf(stderr, "kernel_launch: unexpected shapes: n_in %d out %d ws %zu (need %zu)\n", n_in, out_size, ws_size, (size_t)WS_END); grid = -1; return; }
        int dev = 0, cus = 0, per_cu = 0;
        if (hipGetDevice(&dev) != hipSuccess || hipDeviceGetAttribute(&cus, hipDeviceAttributeMultiprocessorCount, dev) != hipSuccess) { grid = -1; return; }
        if (hipFuncSetAttribute((const void*)fwd, hipFuncAttributeMaxDynamicSharedMemorySize, LDS_BYTES) != hipSuccess) { fprintf(stderr, "kernel_launch: hipFuncSetAttribute failed\n"); grid = -1; return; }
        if (hipOccupancyMaxActiveBlocksPerMultiprocessor(&per_cu, (const void*)fwd, NWAVES * 64, LDS_BYTES) != hipSuccess || per_cu < 1) { fprintf(stderr, "kernel_launch: occupancy query says %d\n", per_cu); (void)hipGetLastError(); grid = -1; return; }
        if (cus != 256) { fprintf(stderr, "kernel_launch: built for a 256-CU device, found %d CUs; nothing launched\n", cus); grid = -1; return; }
        grid = cus;
    }
    if (grid < 0) return;
    if (hipMemsetAsync((char*)d_ws + WS_CTL, 0, CTL_ZERO_BYTES, stream) != hipSuccess) return;
    Args a{};
    for (int i = 0; i < 27; ++i) a.in[i] = (const float*)d_in[i];
    a.out = (float*)d_out; a.ws = (unsigned char*)d_ws;
#if defined(MK_PROBE_DUP)
    a.ph_lo = 0; a.ph_hi = MK_PROBE_DUP + 1; hipLaunchKernelGGL(fwd, dim3(grid), dim3(NWAVES * 64), LDS_BYTES, stream, a);
    (void)hipMemsetAsync((char*)d_ws + WS_CTL, 0, CTL_ZERO_BYTES, stream);
    a.ph_lo = MK_PROBE_DUP; a.ph_hi = N_PHASES; hipLaunchKernelGGL(fwd, dim3(grid), dim3(NWAVES * 64), LDS_BYTES, stream, a);
#else
    for (int li = 0; li < N_LAUNCHES; ++li) {
        a.ph_lo = (N_LAUNCHES == 1) ? 0 : li; a.ph_hi = (N_LAUNCHES == 1) ? N_PHASES : li + 1;
        hipLaunchKernelGGL(fwd, dim3(grid), dim3(NWAVES * 64), LDS_BYTES, stream, a);
        if (hipPeekAtLastError() != hipSuccess) { fprintf(stderr, "kernel_launch: launch %d failed\n", li); break; }
    }
#endif
}
```

```cpp
#include <hip/hip_runtime.h>
#include <cstdio>
#include <cstdint>
#define MK_N_LAUNCHES 1
namespace pg8 {
#define PG8_LAS __attribute__((address_space(3)))
typedef unsigned short bf16_t;
typedef short bf16x8 __attribute__((ext_vector_type(8)));
typedef float f32x4 __attribute__((ext_vector_type(4)));
typedef unsigned u32x4 __attribute__((ext_vector_type(4)));
constexpr int BM = 256, BK = 64, HALF = 128, HTB = HALF * BK * 2  , STAGE_BYTES = 8 * HTB, NXCD = 8, WGM = 8;

__host__ __device__ __forceinline__ int lds_byte(int r, int c) { const int st = (r >> 4) * 2 + (c >> 5), rr = r & 15, cc = c & 31, ob = rr * 64 + cc * 2; return st * 1024 + (ob ^ (((ob >> 9) & 1) << 5)); }
__host__ __device__ __forceinline__ void stage_rc(int b, int& R, int& C) { const int st = b / 1024, sb = b % 1024, swz = sb ^ (((sb >> 9) & 1) << 5); R = (st >> 1) * 16 + swz / 64; C = (st & 1) * 32 + (swz % 64) / 2; }
__host__ __device__ __forceinline__ int perm32(int rho) { const int n = rho >> 4, i = rho & 15; return 8 * (i >> 2) + 4 * n + (i & 3); }

struct Unit { int pm, pn, kt0, nkt, part; };
struct Gemm { const bf16_t* A; const bf16_t* Bt; int M, N, K; };

__device__ __forceinline__ long long pack_unit(int pm, int pn, int part, int kt0, int nkt) { return (long long)(unsigned)(pm | (pn << 8) | (part << 16) | (kt0 << 20)) | ((long long)nkt << 32); }
__device__ __forceinline__ Unit unpack_unit(long long d) { const unsigned lo = (unsigned)d; Unit u; u.pm = lo & 255; u.pn = (lo >> 8) & 255; u.part = (lo >> 16) & 15; u.kt0 = lo >> 20; u.nkt = (int)(d >> 32); return u; }
template <int M_, int N_, int K_> struct StaticOrderT {
    static constexpr int nM = M_ / BM, nN = N_ / BM, nwg = nM * nN, nktf = K_ / BK;
    int G, c;
    __device__ __forceinline__ void init(int G_, int c_) { G = G_; c = c_; }
    __device__ __forceinline__ long long next(int i) const { const int L = i * G + c; return L >= nwg ? -1ll : map(L); }
    __device__ __forceinline__ int max_units() const { return (nwg + G - 1) / G; }
    __device__ __forceinline__ static long long map(int L) {
        int wgid = L; { constexpr int q = nwg / NXCD, r = nwg % NXCD; const int xcd = wgid % NXCD, off = wgid / NXCD; wgid = (xcd < r ? xcd * (q + 1) : r * (q + 1) + (xcd - r) * q) + off; }
        constexpr int nig = WGM * nN; const int gid = wgid / nig, fm = gid * WGM, gsz = (nM - fm) < WGM ? (nM - fm) : WGM;
        return pack_unit(fm + ((wgid % nig) % gsz), (wgid % nig) / gsz, 0, 0, nktf);
    }
};
template <int MW_, int M_, int N_, int K_, int SPLIT> struct TailSplitOrderT {
    typedef StaticOrderT<MW_, N_, K_> WO;
    static constexpr int nMw = MW_ / BM, nN = N_ / BM, nTail = (M_ - MW_) / BM * nN, np = K_ / BK / 2, base = np / SPLIT, rem = np % SPLIT;
    WO W; int nwhole;
    __device__ __forceinline__ void init(int G_, int c_) { W.init(G_, c_); nwhole = c_ < WO::nwg ? (WO::nwg - c_ + G_ - 1) / G_ : 0; }
    __device__ __forceinline__ long long next(int i) const {
        if (i < nwhole) return W.next(i);
        if (i != nwhole || W.c >= nTail * SPLIT) return -1ll;
        const int part = W.c % SPLIT, tu = W.c / SPLIT;
        return pack_unit(nMw + tu / nN, tu % nN, part, 2 * (part * base + (part < rem ? part : rem)), 2 * (base + (part < rem ? 1 : 0)));
    }
    __device__ __forceinline__ int max_units() const { return W.max_units() + 1; }
};
template <int M_, int N_, int K_, int SPLIT, int GRID> struct RoundsTailOrderT {
    typedef StaticOrderT<M_, N_, K_> WO;
    static constexpr int R = WO::nwg / GRID, nTail = WO::nwg % GRID, nkp = K_ / BK / SPLIT;
    static_assert(nTail * SPLIT <= GRID && nkp % 2 == 0 && nkp >= 2 && nkp * SPLIT * BK == K_, "RoundsTailOrderT geometry");
    int c;
    __device__ __forceinline__ void init(int c_) { c = c_; }
    __device__ __forceinline__ long long next(int i) const {
        if (i < R) return WO::map(i * GRID + c);
        if (i != R || c >= nTail * SPLIT) return -1ll;
        const Unit u = unpack_unit(WO::map(R * GRID + c / SPLIT)); const int part = c % SPLIT;
        return pack_unit(u.pm, u.pn, 1 + part, part * nkp, nkp);
    }
    __device__ __forceinline__ int max_units() const { return R + (nTail ? 1 : 0); }
};
__device__ __forceinline__ unsigned cvt_pk_bf16(float lo, float hi) { unsigned r; asm volatile("v_cvt_pk_bf16_f32 %0, %1, %2" : "=v"(r) : "v"(lo), "v"(hi)); return r; }
typedef float f32x2 __attribute__((ext_vector_type(2)));
struct NoHook { __device__ __forceinline__ void operator()() const {} };
typedef int i32x4 __attribute__((ext_vector_type(4)));
template <bool I8> __device__ __forceinline__ f32x4 mma1(bf16x8 b, bf16x8 a, f32x4 c) {
    if constexpr (I8) return __builtin_bit_cast(f32x4, __builtin_amdgcn_mfma_i32_16x16x64_i8(__builtin_bit_cast(i32x4, b), __builtin_bit_cast(i32x4, a), __builtin_bit_cast(i32x4, c), 0, 0, 0));
    else return __builtin_amdgcn_mfma_f32_16x16x32_bf16(b, a, c, 0, 0, 0);
}
template <class Epi, class Sched, bool ALIGN_EPI = false, bool SP2 = false, class Hook = NoHook, bool I8 = false>
__device__ __forceinline__ void gemm_phase(PG8_LAS unsigned char* lds, const Gemm g, const Sched& S, const Epi& E, const Hook& hook = Hook()) {
    const int tid = threadIdx.x, wid = __builtin_amdgcn_readfirstlane(tid >> 6), lane = tid & 63, wr = wid >> 2, wc = wid & 3, fr = lane & 15, fq = lane >> 4;
    const int K = g.K;
    unsigned voffA[2], voffB[2];
#pragma unroll
    for (int i = 0; i < 2; ++i) { int R, C; stage_rc(tid * 16 + i * 8192, R, C); const int Rb = Epi::PERM ? ((R & ~31) + perm32(R & 31)) : R;
        voffA[i] = (unsigned)(R * K + C) * 2u; voffB[i] = (unsigned)(Rb * K + C) * 2u; }
    const size_t kstep = (size_t)(BK * 2);
    const size_t hstep = (size_t)HALF * K * 2;
    const size_t tstep = 2 * hstep;
    const unsigned ldsw = (unsigned)wid * 1024u;
    const int aoff = lds_byte(wr * 64 + fr, fq * 8), boff = lds_byte(wc * 32 + fr, fq * 8);
#define PG8_SA(b, h) (((b) * 2 + (h)) * HTB)
#define PG8_SB(b, h) ((4 + (b) * 2 + (h)) * HTB)
#define PG8_STAGE(bufoff, gbase, voff) do { _Pragma("unroll") for (int _i = 0; _i < 2; ++_i) \
        __builtin_amdgcn_global_load_lds((const unsigned*)((const char*)(gbase) + (voff)[_i]), (PG8_LAS unsigned*)(lds + (bufoff) + ldsw + _i * 8192), 16, 0, 0); } while (0)
#define PG8_LDA(dst, b, h) do { _Pragma("unroll") for (int m = 0; m < 4; ++m) _Pragma("unroll") for (int k = 0; k < 2; ++k) dst[m][k] = *(const PG8_LAS bf16x8*)(lds + PG8_SA(b, h) + aoff + m * 2048 + k * 1024); } while (0)
#define PG8_LDB(dst, b, h) do { _Pragma("unroll") for (int n = 0; n < 2; ++n) _Pragma("unroll") for (int k = 0; k < 2; ++k) dst[n][k] = *(const PG8_LAS bf16x8*)(lds + PG8_SB(b, h) + boff + n * 2048 + k * 1024); } while (0)
#define PG8_MMA(ai, bj, At, Bt) do { __builtin_amdgcn_s_setprio(1); _Pragma("unroll") for (int k = 0; k < 2; ++k) _Pragma("unroll") for (int m = 0; m < 4; ++m) _Pragma("unroll") for (int n = 0; n < 2; ++n) \
        acc[ai][bj][m][n] = mma1<I8>(Bt[n][k], At[m][k], acc[ai][bj][m][n]); __builtin_amdgcn_s_setprio(0); } while (0)
#define PG8_WAIT_V(n) asm volatile("s_waitcnt vmcnt(" #n ")" ::: "memory")
#define PG8_WAIT_L(n) asm volatile("s_waitcnt lgkmcnt(" #n ")" ::: "memory")
#define PG8_BAR __builtin_amdgcn_s_barrier()
#define PG8_SCHED __builtin_amdgcn_sched_barrier(0)
    int ui = 0, c_pm, c_pn, c_kt0, c_nkt, c_part;
    int nhook = S.max_units() - 1;
    { const long long d0 = S.next(0); if (d0 < 0) { for (; nhook > 0; --nhook) hook(); return; } const Unit u0 = unpack_unit(d0); c_pm = u0.pm; c_pn = u0.pn; c_kt0 = u0.kt0; c_nkt = u0.nkt; c_part = u0.part; }
    f32x4 acc[2][2][4][2];
#pragma unroll
    for (int a = 0; a < 2; ++a)
#pragma unroll
        for (int b = 0; b < 2; ++b)
#pragma unroll
            for (int m = 0; m < 4; ++m)
#pragma unroll
                for (int n = 0; n < 2; ++n) acc[a][b][m][n] = (f32x4){0.f, 0.f, 0.f, 0.f};
    bf16x8 At[4][2], B0[2][2], B1[2][2];
    const char* cA = (const char*)g.A + (size_t)c_pm * tstep + (size_t)c_kt0 * kstep; const char* cB = (const char*)g.Bt + (size_t)c_pn * tstep + (size_t)c_kt0 * kstep;
    if constexpr (SP2) {
        PG8_STAGE(PG8_SB(0, 0), cB, voffB); PG8_STAGE(PG8_SB(0, 1), cB + hstep, voffB); PG8_STAGE(PG8_SA(0, 0), cA, voffA); PG8_STAGE(PG8_SA(0, 1), cA + hstep, voffA);
        if (wr == 1) PG8_BAR;
        PG8_WAIT_V(2); PG8_BAR;
        PG8_STAGE(PG8_SB(1, 0), cB + kstep, voffB); PG8_STAGE(PG8_SA(1, 0), cA + kstep, voffA); PG8_STAGE(PG8_SB(1, 1), cB + hstep + kstep, voffB);
        PG8_WAIT_V(6); PG8_BAR;
    } else {
        PG8_STAGE(PG8_SB(0, 0), cB, voffB); PG8_STAGE(PG8_SA(0, 0), cA, voffA); PG8_STAGE(PG8_SB(0, 1), cB + hstep, voffB); PG8_STAGE(PG8_SA(0, 1), cA + hstep, voffA);
        if (wr == 1) PG8_BAR;
        PG8_WAIT_V(4); PG8_BAR;
        PG8_STAGE(PG8_SB(1, 0), cB + kstep, voffB); PG8_STAGE(PG8_SA(1, 0), cA + kstep, voffA); PG8_STAGE(PG8_SB(1, 1), cB + hstep + kstep, voffB);
        PG8_WAIT_V(6); PG8_BAR;
    }
    for (;;) {
        bool has_next; const char* nA; const char* nB;
        { const long long dn = S.next(ui + 1); has_next = dn >= 0; const Unit nxt = unpack_unit(dn);
          nA = has_next ? (const char*)g.A + (size_t)nxt.pm * tstep + (size_t)nxt.kt0 * kstep : cA; nB = has_next ? (const char*)g.Bt + (size_t)nxt.pn * tstep + (size_t)nxt.kt0 * kstep : cB; }
        const int nt = c_nkt;
        for (int t = 0; t < nt; t += 2) {
            const bool last = (t == nt - 2);
            const char* a1 = cA + (size_t)(t + 1) * kstep;
            const char* a2 = last ? nA : cA + (size_t)(t + 2) * kstep; const char* b2 = last ? nB : cB + (size_t)(t + 2) * kstep;
            const char* a3 = a2 + kstep; const char* b3 = b2 + kstep;
            if constexpr (SP2) {
            PG8_LDB(B0, 0, 0); PG8_LDB(B1, 0, 1); PG8_SCHED; PG8_LDA(At, 0, 0); PG8_STAGE(PG8_SA(1, 1), a1 + hstep, voffA);
            PG8_WAIT_V(8); PG8_WAIT_L(0); PG8_BAR; PG8_MMA(0, 0, At, B0); PG8_MMA(0, 1, At, B1); PG8_BAR; PG8_SCHED;
            PG8_LDA(At, 0, 1); PG8_STAGE(PG8_SB(0, 0), b2, voffB); PG8_STAGE(PG8_SB(0, 1), b2 + hstep, voffB); PG8_STAGE(PG8_SA(0, 0), a2, voffA);
            PG8_WAIT_V(8); PG8_WAIT_L(0); PG8_BAR; PG8_MMA(1, 0, At, B0); PG8_MMA(1, 1, At, B1); PG8_BAR; PG8_SCHED;
            PG8_LDB(B0, 1, 0); PG8_LDB(B1, 1, 1); PG8_SCHED; PG8_LDA(At, 1, 0); PG8_STAGE(PG8_SA(0, 1), a2 + hstep, voffA);
            PG8_WAIT_V(8); PG8_WAIT_L(0); PG8_BAR; PG8_MMA(0, 0, At, B0); PG8_MMA(0, 1, At, B1); PG8_BAR; PG8_SCHED;
            PG8_LDA(At, 1, 1); PG8_STAGE(PG8_SB(1, 0), b3, voffB); PG8_STAGE(PG8_SB(1, 1), b3 + hstep, voffB); PG8_STAGE(PG8_SA(1, 0), a3, voffA);
            PG8_WAIT_V(8); PG8_WAIT_L(0); PG8_BAR; PG8_MMA(1, 0, At, B0); PG8_MMA(1, 1, At, B1); PG8_BAR; PG8_SCHED;
            } else {
            PG8_LDB(B0, 0, 0); PG8_SCHED; PG8_LDA(At, 0, 0); PG8_STAGE(PG8_SA(1, 1), a1 + hstep, voffA);
            PG8_WAIT_L(8); PG8_BAR; PG8_WAIT_L(0); PG8_MMA(0, 0, At, B0); PG8_BAR; PG8_SCHED;
            PG8_LDB(B1, 0, 1); PG8_STAGE(PG8_SB(0, 0), b2, voffB);
            PG8_BAR; PG8_WAIT_L(0); PG8_MMA(0, 1, At, B1); PG8_BAR;
            PG8_LDA(At, 0, 1); PG8_STAGE(PG8_SA(0, 0), a2, voffA);
            PG8_BAR; PG8_WAIT_L(0); PG8_MMA(1, 0, At, B0); PG8_BAR; PG8_SCHED;
            PG8_STAGE(PG8_SB(0, 1), b2 + hstep, voffB);
            PG8_WAIT_V(6); PG8_BAR; PG8_MMA(1, 1, At, B1); PG8_BAR;
            PG8_LDB(B0, 1, 0); PG8_SCHED; PG8_LDA(At, 1, 0); PG8_STAGE(PG8_SA(0, 1), a2 + hstep, voffA);
            PG8_WAIT_L(8); PG8_BAR; PG8_WAIT_L(0); PG8_MMA(0, 0, At, B0); PG8_BAR; PG8_SCHED;
            PG8_LDB(B1, 1, 1); PG8_STAGE(PG8_SB(1, 0), b3, voffB);
            PG8_BAR; PG8_WAIT_L(0); PG8_MMA(0, 1, At, B1); PG8_BAR;
            PG8_LDA(At, 1, 1); PG8_STAGE(PG8_SA(1, 0), a3, voffA);
            PG8_BAR; PG8_WAIT_L(0); PG8_MMA(1, 0, At, B0); PG8_BAR; PG8_SCHED;
            PG8_STAGE(PG8_SB(1, 1), b3 + hstep, voffB);
            PG8_WAIT_V(6); PG8_BAR; PG8_MMA(1, 1, At, B1); PG8_BAR;
            }
        }
        if constexpr (ALIGN_EPI) { if (wr == 0) PG8_BAR; }
        if constexpr (I8) {
#pragma unroll
            for (int a = 0; a < 2; ++a)
#pragma unroll
                for (int bq = 0; bq < 2; ++bq)
#pragma unroll
                    for (int m = 0; m < 4; ++m)
#pragma unroll
                        for (int n = 0; n < 2; ++n) acc[a][bq][m][n] = __builtin_convertvector(__builtin_bit_cast(i32x4, acc[a][bq][m][n]), f32x4); }
        if constexpr (!Epi::AFTER_DRAIN) { const Unit cu{c_pm, c_pn, c_kt0, c_nkt, c_part}; E(acc, cu, wr, wc, fr, fq); }
        if (!has_next) break;
        hook(); --nhook;
#pragma unroll
        for (int a = 0; a < 2; ++a)
#pragma unroll
            for (int b = 0; b < 2; ++b)
#pragma unroll
                for (int m = 0; m < 4; ++m)
#pragma unroll
                    for (int n = 0; n < 2; ++n) acc[a][b][m][n] = (f32x4){0.f, 0.f, 0.f, 0.f};
        ++ui; { int uj = ui; asm volatile("" : "+s"(uj)); const Unit u1 = unpack_unit(S.next(uj)); c_pm = u1.pm; c_pn = u1.pn; c_kt0 = u1.kt0; c_nkt = u1.nkt; c_part = u1.part; } cA = nA; cB = nB;
        if constexpr (ALIGN_EPI) { if (wr == 1) PG8_BAR; }
    }
    PG8_WAIT_V(0);
    if constexpr (!ALIGN_EPI) { if (wr == 0) PG8_BAR; }
    PG8_BAR;
    for (; nhook > 0; --nhook) hook();
    if constexpr (Epi::AFTER_DRAIN) { const Unit cu{c_pm, c_pn, c_kt0, c_nkt, c_part}; E.fused(acc, cu, wr, wc, fr, fq, lds, wid, lane); }
#undef PG8_SA
#undef PG8_SB
#undef PG8_STAGE
#undef PG8_LDA
#undef PG8_LDB
#undef PG8_MMA
#undef PG8_WAIT_V
#undef PG8_WAIT_L
#undef PG8_BAR
#undef PG8_SCHED
}
}
namespace pg8 {
typedef unsigned u32x2 __attribute__((ext_vector_type(2)));
__device__ __forceinline__ float bf_lo(unsigned w) { return __uint_as_float(w << 16); }
__device__ __forceinline__ float bf_hi(unsigned w) { return __uint_as_float(w & 0xffff0000u); }
__device__ __forceinline__ float sigm(float x) { return __builtin_amdgcn_rcpf(1.0f + __builtin_amdgcn_exp2f(-1.44269504089f * x)); }
__device__ __forceinline__ f32x4 sigm4(f32x4 v) { return (f32x4){sigm(v[0]), sigm(v[1]), sigm(v[2]), sigm(v[3])}; }
__device__ __forceinline__ u32x4 pack8(f32x4 v0, f32x4 v1) { u32x4 w; w.x = cvt_pk_bf16(v0[0], v0[1]); w.y = cvt_pk_bf16(v0[2], v0[3]); w.z = cvt_pk_bf16(v1[0], v1[1]); w.w = cvt_pk_bf16(v1[2], v1[3]); return w; }
__device__ __forceinline__ void unpack8(u32x4 w, f32x4& v0, f32x4& v1) { v0 = (f32x4){bf_lo(w.x), bf_hi(w.x), bf_lo(w.y), bf_hi(w.y)}; v1 = (f32x4){bf_lo(w.z), bf_hi(w.z), bf_lo(w.w), bf_hi(w.w)}; }

__device__ __forceinline__ unsigned pack4u(f32x4 v) { unsigned w = 0u;
    w = __builtin_amdgcn_cvt_pk_u8_f32(__builtin_rintf(v[0] * 255.0f), 0, w); w = __builtin_amdgcn_cvt_pk_u8_f32(__builtin_rintf(v[1] * 255.0f), 1, w);
    w = __builtin_amdgcn_cvt_pk_u8_f32(__builtin_rintf(v[2] * 255.0f), 2, w); w = __builtin_amdgcn_cvt_pk_u8_f32(__builtin_rintf(v[3] * 255.0f), 3, w); return w; }
__device__ __forceinline__ u32x2 pack8u(f32x4 v0, f32x4 v1) { u32x2 w; w.x = pack4u(v0); w.y = pack4u(v1); return w; }
__device__ __forceinline__ f32x4 unpack4u(unsigned w) { return (f32x4){(float)(w & 255u), (float)((w >> 8) & 255u), (float)((w >> 16) & 255u), (float)(w >> 24)} * (1.0f / 255.0f); }
__device__ __forceinline__ void unpack8u(u32x2 w, f32x4& v0, f32x4& v1) { v0 = unpack4u(w.x); v1 = unpack4u(w.y); }

#ifndef PG8_WT
#define PG8_WT 0
#endif
struct OutBuf { __amdgpu_buffer_rsrc_t r;
    __device__ __forceinline__ OutBuf(const void* base, size_t bytes) : r(__builtin_amdgcn_make_buffer_rsrc((void*)base, (short)0, (int)bytes, 0x00020000)) {}
    __device__ __forceinline__ void st(unsigned voff, unsigned soff, u32x4 v) const { __builtin_amdgcn_raw_buffer_store_b128(v, r, (int)(voff + soff), 0, PG8_WT); }
    __device__ __forceinline__ u32x4 ld(unsigned voff) const { return __builtin_amdgcn_raw_buffer_load_b128(r, (int)voff, 0, 0); }
    __device__ __forceinline__ void st8(unsigned voff, u32x2 v) const { __builtin_amdgcn_raw_buffer_store_b64(v, r, (int)voff, 0, PG8_WT); }
    __device__ __forceinline__ u32x2 ld8(unsigned voff) const { return __builtin_amdgcn_raw_buffer_load_b64(r, (int)voff, 0, 0); }
    __device__ __forceinline__ void stf(unsigned voff, unsigned soff, f32x4 v) const { __builtin_amdgcn_raw_buffer_store_b128(__builtin_bit_cast(u32x4, v), r, (int)(voff + soff), 0, PG8_WT); } };
struct EpiProj {
    static constexpr bool PERM = true, AFTER_DRAIN = false;
    bf16_t *U, *Z, *CB, *SGA, *SGB;
    __device__ __forceinline__ void operator()(const f32x4 (&acc)[2][2][4][2], const Unit& u, int wr, int wc, int fr, int fq) const {
        const int row0 = u.pm * BM + wr * 64 + fr, cw = wc * 32 + 8 * fq, pn = u.pn;
        if (pn >= 8 && pn < 24) {
            const OutBuf ob(Z, (size_t)9216 * 2048 * 2); const unsigned v0 = (unsigned)(row0 * 2048 + (pn - 8) * 128 + cw) * 2u;
#pragma unroll
            for (int ai = 0; ai < 2; ++ai)
#pragma unroll
                for (int m = 0; m < 4; ++m) ob.st(v0, (unsigned)(ai * HALF + m * 16) * 2048u * 2u, pack8(acc[ai][0][m][0] * acc[ai][1][m][0], acc[ai][0][m][1] * acc[ai][1][m][1]));
        } else {
            bf16_t* base; int ldc, cb; bool sg;
            if (pn < 8) { base = U; cb = pn * 256; ldc = 2048; sg = false; }
            else if (pn < 32) { base = CB; cb = (pn - 24) * 256; ldc = 2048; sg = false; }
            else if (pn < 48) { base = SGA; cb = (pn - 32) * 256; ldc = 4096; sg = true; }
            else { base = SGB; cb = (pn - 48) * 256; ldc = 4096; sg = true; }
            const OutBuf ob(base, (size_t)9216 * ldc * 2); const unsigned v0 = (unsigned)(row0 * ldc + cb + cw) * 2u;
#pragma unroll
            for (int ai = 0; ai < 2; ++ai)
#pragma unroll
                for (int m = 0; m < 4; ++m)
#pragma unroll
                    for (int bj = 0; bj < 2; ++bj) { f32x4 v0f = acc[ai][bj][m][0], v1f = acc[ai][bj][m][1];
                        if (sg) { v0f = sigm4(v0f); v1f = sigm4(v1f); }
                        ob.st(v0, (unsigned)((ai * HALF + m * 16) * ldc + bj * HALF) * 2u, pack8(v0f, v1f)); }
        }
    }
};
struct EpiGlu {
    static constexpr bool PERM = true, AFTER_DRAIN = false;
    const bf16_t* SGA; bf16_t* M1;
    __device__ __forceinline__ void operator()(const f32x4 (&acc)[2][2][4][2], const Unit& u, int wr, int wc, int fr, int fq) const {
        const int row0 = u.pm * BM + wr * 64 + fr, col = u.pn * 128 + wc * 32 + 8 * fq; const OutBuf ob(M1, (size_t)9216 * 4096 * 2), ib(SGA, (size_t)9216 * 4096);
#pragma unroll
        for (int ai = 0; ai < 2; ++ai)
#pragma unroll
            for (int m = 0; m < 4; ++m) { const unsigned off = (unsigned)((row0 + ai * HALF + m * 16) * 4096 + col);
                f32x4 s0, s1; unpack8u(ib.ld8(off), s0, s1);
                const f32x4 o0 = s0 * acc[ai][0][m][0] * sigm4(acc[ai][1][m][0]), o1 = s1 * acc[ai][0][m][1] * sigm4(acc[ai][1][m][1]);
                ob.st((unsigned)off * 2u, 0u, pack8(o0, o1)); }
    }
};
struct EpiGluMerge {
    static constexpr bool PERM = true, AFTER_DRAIN = false;
    const bf16_t *SGA, *SGB, *CO; bf16_t* GS; bf16_t* MG; int MW, MT;
    __device__ __forceinline__ void operator()(const f32x4 (&acc)[2][2][4][2], const Unit& u, int wr, int wc, int fr, int fq) const {
        const int row0 = u.pm * BM + wr * 64 + fr, col = u.pn * 128 + wc * 32 + 8 * fq;
        const OutBuf ob(MG, (size_t)9216 * 4096 * 2), ia(SGA, (size_t)9216 * 4096), ib(SGB, (size_t)9216 * 4096);
        if (u.pm * BM < MW) {
            const OutBuf ic(CO, (size_t)9216 * 4096 * 2);
            u32x2 ga[2][4], gb[2][4]; u32x4 cc[2][4];
#pragma unroll
            for (int ai = 0; ai < 2; ++ai)
#pragma unroll
                for (int m = 0; m < 4; ++m) { const unsigned off = (unsigned)((row0 + ai * HALF + m * 16) * 4096 + col); ga[ai][m] = ia.ld8(off); gb[ai][m] = ib.ld8(off); cc[ai][m] = ic.ld(off * 2u); }
            __builtin_amdgcn_sched_barrier(0);
#pragma unroll
            for (int ai = 0; ai < 2; ++ai)
#pragma unroll
                for (int m = 0; m < 4; ++m) { const unsigned off = (unsigned)((row0 + ai * HALF + m * 16) * 4096 + col);
                    f32x4 a0, a1, b0, b1, c0, c1; unpack8u(ga[ai][m], a0, a1); unpack8u(gb[ai][m], b0, b1); unpack8(cc[ai][m], c0, c1);
                    const f32x4 o0 = a0 * acc[ai][0][m][0] * sigm4(acc[ai][1][m][0]) + b0 * c0, o1 = a1 * acc[ai][0][m][1] * sigm4(acc[ai][1][m][1]) + b1 * c1;
                    ob.st(off * 2u, 0u, pack8(o0, o1)); }
        } else {
            const OutBuf og(GS, (size_t)2 * MT * 8192 * 2); const unsigned v0 = (unsigned)((u.part * MT + (row0 - MW)) * 8192 + u.pn * BM + wc * 32 + 8 * fq) * 2u;
#pragma unroll
            for (int ai = 0; ai < 2; ++ai)
#pragma unroll
                for (int m = 0; m < 4; ++m)
#pragma unroll
                    for (int bj = 0; bj < 2; ++bj) og.st(v0, (unsigned)((ai * HALF + m * 16) * 8192 + bj * HALF) * 2u, pack8(acc[ai][bj][m][0], acc[ai][bj][m][1]));
        }
    }
};
struct EpiConvOut {
    static constexpr bool PERM = true, AFTER_DRAIN = false;
    const bf16_t *SGB, *M1; bf16_t* MG; bf16_t* XT; int MW, MT;
    __device__ __forceinline__ void operator()(const f32x4 (&acc)[2][2][4][2], const Unit& u, int wr, int wc, int fr, int fq) const {
        const int row0 = u.pm * BM + wr * 64 + fr, col = u.pn * BM + wc * 32 + 8 * fq; const OutBuf ob(MG, (size_t)9216 * 4096 * 2), ig(SGB, (size_t)9216 * 4096), im(M1, (size_t)9216 * 4096 * 2);
        if (row0 >= MW) {
            const OutBuf xb(XT, (size_t)4 * MT * 4096 * 2); const unsigned v0 = (unsigned)((u.part * MT + (row0 - MW)) * 4096 + col) * 2u;
#pragma unroll
            for (int ai = 0; ai < 2; ++ai)
#pragma unroll
                for (int m = 0; m < 4; ++m)
#pragma unroll
                    for (int bj = 0; bj < 2; ++bj) xb.st(v0, (unsigned)((ai * HALF + m * 16) * 4096 + bj * HALF) * 2u, pack8(acc[ai][bj][m][0], acc[ai][bj][m][1]));
            return;
        }
#pragma unroll
        for (int ai = 0; ai < 2; ++ai)
#pragma unroll
            for (int m = 0; m < 4; ++m)
#pragma unroll
                for (int bj = 0; bj < 2; ++bj) { const unsigned off = (unsigned)((row0 + ai * HALF + m * 16) * 4096 + col + bj * HALF);
                    f32x4 s0, s1, a0, a1; unpack8u(ig.ld8(off), s0, s1); unpack8(im.ld(off * 2u), a0, a1);
                    ob.st((unsigned)off * 2u, 0u, pack8(a0 + s0 * acc[ai][bj][m][0], a1 + s1 * acc[ai][bj][m][1])); }
    }
};
struct EpiBf16Parts {
    static constexpr bool PERM = true, AFTER_DRAIN = false;
    bf16_t* C; bf16_t* XT; int MW, MT;
    __device__ __forceinline__ void operator()(const f32x4 (&acc)[2][2][4][2], const Unit& u, int wr, int wc, int fr, int fq) const {
        const int row0 = u.pm * BM + wr * 64 + fr, col = u.pn * BM + wc * 32 + 8 * fq;
        if (row0 < MW) {
            const OutBuf ob(C, (size_t)9216 * 4096 * 2); const unsigned v0 = (unsigned)(row0 * 4096 + col) * 2u;
#pragma unroll
            for (int ai = 0; ai < 2; ++ai)
#pragma unroll
                for (int m = 0; m < 4; ++m)
#pragma unroll
                    for (int bj = 0; bj < 2; ++bj) ob.st(v0, (unsigned)((ai * HALF + m * 16) * 4096 + bj * HALF) * 2u, pack8(acc[ai][bj][m][0], acc[ai][bj][m][1]));
        } else {
            const OutBuf ob(XT, (size_t)4 * MT * 4096 * 2); const unsigned v0 = (unsigned)((u.part * MT + (row0 - MW)) * 4096 + col) * 2u;
#pragma unroll
            for (int ai = 0; ai < 2; ++ai)
#pragma unroll
                for (int m = 0; m < 4; ++m)
#pragma unroll
                    for (int bj = 0; bj < 2; ++bj) ob.st(v0, (unsigned)((ai * HALF + m * 16) * 4096 + bj * HALF) * 2u, pack8(acc[ai][bj][m][0], acc[ai][bj][m][1]));
        }
    }
};
struct EpiSwiGlu {
    static constexpr bool PERM = true, AFTER_DRAIN = false;
    bf16_t* H; f32x4* XS;
    __device__ __forceinline__ void operator()(const f32x4 (&acc)[2][2][4][2], const Unit& u, int wr, int wc, int fr, int fq) const {
        if (u.part != 0) {
            const OutBuf ob(XS, (size_t)192 * 16 * 512 * 16); const unsigned v0 = ((unsigned)blockIdx.x * 16u * 512u + threadIdx.x) * 16u;
#pragma unroll
            for (int ai = 0; ai < 2; ++ai)
#pragma unroll
                for (int bj = 0; bj < 2; ++bj)
#pragma unroll
                    for (int m = 0; m < 4; ++m) ob.st(v0, (unsigned)(((ai * 2 + bj) * 4 + m) * 8192), pack8(acc[ai][bj][m][0], acc[ai][bj][m][1]));
            return;
        }
        const int row0 = u.pm * BM + wr * 64 + fr, col = u.pn * 128 + wc * 32 + 8 * fq;
        const OutBuf ob(H, (size_t)9216 * 11008 * 2); const unsigned v0 = (unsigned)(row0 * 11008 + col) * 2u;
#pragma unroll
        for (int ai = 0; ai < 2; ++ai)
#pragma unroll
            for (int m = 0; m < 4; ++m) { const f32x4 g0 = acc[ai][0][m][0], g1 = acc[ai][0][m][1];
                ob.st(v0, (unsigned)((ai * HALF + m * 16) * 11008) * 2u, pack8(g0 * sigm4(g0) * acc[ai][1][m][0], g1 * sigm4(g1) * acc[ai][1][m][1])); }
    }
};
struct EpiGateI8 {
    static constexpr bool PERM = true, AFTER_DRAIN = false;
    bf16_t *SGA, *SGB; const float* SA; const float* SB;
    __device__ __forceinline__ void operator()(const f32x4 (&acc)[2][2][4][2], const Unit& u, int wr, int wc, int fr, int fq) const {
        const int row0 = u.pm * BM + wr * 64 + fr, cw = wc * 32 + 8 * fq, cq = u.pn * BM + cw;
        const OutBuf ob(u.pn < 16 ? SGA : SGB, (size_t)9216 * 4096); const unsigned v0 = (unsigned)(row0 * 4096 + (u.pn & 15) * 256 + cw);
        f32x4 sb[2][2];
#pragma unroll
        for (int bj = 0; bj < 2; ++bj) { sb[bj][0] = *(const f32x4*)(SB + cq + bj * HALF); sb[bj][1] = *(const f32x4*)(SB + cq + bj * HALF + 4); }
        float sav[2][4];
#pragma unroll
        for (int ai = 0; ai < 2; ++ai)
#pragma unroll
            for (int m = 0; m < 4; ++m) sav[ai][m] = SA[row0 + ai * HALF + m * 16];
        __builtin_amdgcn_sched_barrier(0);
#pragma unroll
        for (int ai = 0; ai < 2; ++ai)
#pragma unroll
            for (int m = 0; m < 4; ++m) { const float sa = sav[ai][m];
#pragma unroll
                for (int bj = 0; bj < 2; ++bj)
                    ob.st8(v0 + (unsigned)((ai * HALF + m * 16) * 4096 + bj * HALF), pack8u(sigm4(acc[ai][bj][m][0] * (sb[bj][0] * sa)), sigm4(acc[ai][bj][m][1] * (sb[bj][1] * sa)))); }
    }
};
struct EpiSwiGluI8 {
    static constexpr bool PERM = true, AFTER_DRAIN = false;
    bf16_t* H; f32x4* XS; const float* SA; const float* SB;
    __device__ __forceinline__ void operator()(const f32x4 (&acc)[2][2][4][2], const Unit& u, int wr, int wc, int fr, int fq) const {
        if (u.part != 0) {
            const OutBuf ob(XS, (size_t)192 * 16 * 512 * 16); const unsigned v0 = ((unsigned)blockIdx.x * 16u * 512u + threadIdx.x) * 16u;
#pragma unroll
            for (int ai = 0; ai < 2; ++ai)
#pragma unroll
                for (int bj = 0; bj < 2; ++bj)
#pragma unroll
                    for (int m = 0; m < 4; ++m) ob.st(v0, (unsigned)(((ai * 2 + bj) * 4 + m) * 8192), pack8(acc[ai][bj][m][0], acc[ai][bj][m][1]));
            return;
        }
        const int row0 = u.pm * BM + wr * 64 + fr, col = u.pn * 128 + wc * 32 + 8 * fq, cq = u.pn * BM + wc * 32 + 8 * fq;
        const f32x4 sg0 = *(const f32x4*)(SB + cq), sg1 = *(const f32x4*)(SB + cq + 4), su0 = *(const f32x4*)(SB + cq + HALF), su1 = *(const f32x4*)(SB + cq + HALF + 4);
        const OutBuf ob(H, (size_t)9216 * 11008 * 2); const unsigned v0 = (unsigned)(row0 * 11008 + col) * 2u;
        float sav[2][4];
#pragma unroll
        for (int ai = 0; ai < 2; ++ai)
#pragma unroll
            for (int m = 0; m < 4; ++m) sav[ai][m] = SA[row0 + ai * HALF + m * 16];
        __builtin_amdgcn_sched_barrier(0);
#pragma unroll
        for (int ai = 0; ai < 2; ++ai)
#pragma unroll
            for (int m = 0; m < 4; ++m) { const float sa = sav[ai][m];
                const f32x4 g0 = acc[ai][0][m][0] * (sg0 * sa), g1 = acc[ai][0][m][1] * (sg1 * sa);
                ob.st(v0, (unsigned)((ai * HALF + m * 16) * 11008) * 2u, pack8(g0 * sigm4(g0) * (acc[ai][1][m][0] * (su0 * sa)), g1 * sigm4(g1) * (acc[ai][1][m][1] * (su1 * sa)))); }
    }
};
}
constexpr int NWAVES = 8;
constexpr int DM = 4096, NBATCH = 4, SEQ = 2048, NMETA = 16, DBATCH = 128, DSEQ = 8;
constexpr int MP = NBATCH * SEQ, MSMP = DBATCH * DSEQ, M = MP + MSMP;
constexpr int SSMW = 2048, NG = 128, GS = 16, NST = 64, CONVW = 2048, DFF = 11008, INCOLS = 16384;
constexpr int NMETACOLS = 6144;
constexpr float EPS = 1e-6f;
#ifndef MK_N_LAUNCHES
#define MK_N_LAUNCHES 1
#endif
constexpr int N_PHASES = 12;
#ifndef MK_NCONV
#define MK_NCONV 0
#endif
#ifndef MK_P7_TAIL
#define MK_P7_TAIL 1
#endif
constexpr int NCONV = MK_NCONV;
constexpr int N_LAUNCHES = MK_N_LAUNCHES;

constexpr size_t OUT_Y = 0, OUT_PRE = (size_t)M * DM, OUT_PIM = OUT_PRE + NBATCH * NG * NST, OUT_PCV = OUT_PIM + NBATCH * NG * NST,
                 OUT_SRE = OUT_PCV + NBATCH * 2 * CONVW, OUT_SIM = OUT_SRE + (size_t)DBATCH * NG * NST, OUT_SCV = OUT_SIM + (size_t)DBATCH * NG * NST,
                 OUT_END = OUT_SCV + (size_t)DBATCH * 2 * CONVW;

constexpr size_t MiB = 1u << 20;
constexpr size_t WS_CTL = 0, CTL_ZERO_BYTES = 64 * 1024;
constexpr size_t WS_LB = 1 * MiB;
constexpr size_t WS_BB = WS_LB + 256 * 1024;
constexpr size_t WS_PM = WS_BB + 1 * MiB;
constexpr size_t WS_HNM = WS_PM + 384 * 1024;
constexpr size_t WS_SMETA = WS_HNM + 128 * 1024;
constexpr size_t WS_SS1 = 3 * MiB;
constexpr size_t WS_SS2 = WS_SS1 + (size_t)M * 64 * 4;
constexpr size_t WS_WIN = 8 * MiB;
constexpr size_t WS_WGLU = WS_WIN + (size_t)INCOLS * DM * 2;
constexpr size_t WS_WCO = WS_WGLU + (size_t)2 * DM * SSMW * 2;
constexpr size_t WS_WO = WS_WCO + (size_t)DM * CONVW * 2;
constexpr size_t WS_WUP = WS_WO + (size_t)DM * DM * 2;
constexpr size_t WS_WDN = WS_WUP + (size_t)2 * DFF * DM * 2;
constexpr size_t WS_ACT = WS_WDN + (size_t)DM * DFF * 2;
constexpr size_t A36 = (size_t)M * 2048 * 2, A72 = 2 * A36;
constexpr size_t WS_R0 = WS_ACT;
constexpr size_t WS_R1 = WS_R0 + A72;
constexpr size_t WS_R2 = WS_R1 + A72;
constexpr size_t WS_R3 = WS_R2 + A36;
constexpr size_t WS_R4 = WS_R3 + A72;
constexpr size_t WS_R5 = WS_R4 + A72;
constexpr size_t WS_R6 = WS_R5 + A72;
constexpr size_t WS_END = WS_R6 + 2 * A72;
constexpr size_t WS_FR = WS_R6;
constexpr int NFRAG = 84;
constexpr size_t WS_H = WS_R1;
static_assert(WS_SS2 + (size_t)M * 64 * 4 <= WS_WIN && WS_SMETA + 64 * 1024 <= WS_SS1, "small region");
static_assert(WS_H + (size_t)M * DFF * 2 <= WS_R5, "H overlay");
static_assert(WS_END <= 1024 * MiB, "workspace budget");
constexpr int CW_BAR = 1024;
static_assert((CW_BAR + 5504) * 4 <= (int)CTL_ZERO_BYTES, "barrier words inside the memset region");

constexpr int RING_OFF = 0, RING_BYTES = 131072;
constexpr int SSM_WB = 32 * 528;
constexpr int TOT_OFF = 8 * SSM_WB;
constexpr int MISC_OFF = 147456 - 256;
static_assert(TOT_OFF + 8192 <= MISC_OFF && RING_BYTES <= MISC_OFF, "LDS map");
constexpr int LDS_BYTES = 147456;

#define GAS __attribute__((address_space(1)))
#define LAS __attribute__((address_space(3)))
typedef unsigned short bf16;
typedef unsigned v4u __attribute__((ext_vector_type(4)));
typedef unsigned v2u __attribute__((ext_vector_type(2)));
typedef float f32x4 __attribute__((ext_vector_type(4)));
typedef short bf16x8 __attribute__((ext_vector_type(8)));
#define LDS_WAIT() asm volatile("s_waitcnt lgkmcnt(0)" ::: "memory")
#define VM_WAIT() asm volatile("s_waitcnt vmcnt(0)" ::: "memory")
__device__ __forceinline__ unsigned f2bf(float f) { unsigned u = __builtin_bit_cast(unsigned, f); return (u + 0x7fffu + ((u >> 16) & 1u)) >> 16; }
__device__ __forceinline__ unsigned pk2(float lo, float hi) { return f2bf(lo) | (f2bf(hi) << 16); }
__device__ __forceinline__ float bflo(unsigned w) { return __uint_as_float(w << 16); }
__device__ __forceinline__ float bfhi(unsigned w) { return __uint_as_float(w & 0xffff0000u); }
__device__ __forceinline__ float bf1(bf16 b) { return __uint_as_float(((unsigned)b) << 16); }
#define XB_TMO      128
#define XB_XCNT(j)  (256  + 64 * (j))
#define XB_XSUB(j)  (1280 + 64 * (j))
#define XB_XGEN(j)  (2304 + 64 * (j))
#define XB_TOP      3328
#define XB_TOPGEN   3392
#define XCD_BAR_WORDS 3456
#define XB_LSUB(j)  (3456 + 64 * (j))
#define XB_LGEN(j)  (4480 + 64 * (j))
#define XCD_ALL_WORDS 5504
#define XB_SPIN_CAP (1u << 18)

__device__ __forceinline__ unsigned xb_ld(unsigned* p)              { return __hip_atomic_load(p, __ATOMIC_RELAXED, __HIP_MEMORY_SCOPE_AGENT); }
__device__ __forceinline__ unsigned xb_add(unsigned* p, unsigned v) { return __hip_atomic_fetch_add(p, v, __ATOMIC_RELAXED, __HIP_MEMORY_SCOPE_AGENT); }
__device__ __forceinline__ unsigned xb_xcc_id() { return (unsigned)__builtin_amdgcn_s_getreg((3 << 11) | 20) & 0xFu; }
#define XB_SPIN(cond, bar) do { unsigned _sp = 0; while (cond) { __builtin_amdgcn_s_sleep(1); \
    if ((++_sp & 255u) == 0u) { if (xb_ld(&(bar)[XB_TMO])) break; if (_sp > XB_SPIN_CAP) { atomicAdd(&(bar)[XB_TMO], 1u); break; } } } } while (0)

struct XcdBarrier {
    unsigned* bar; unsigned x;
    volatile LAS unsigned* st;
};

__device__ __forceinline__ XcdBarrier xcd_barrier_post(unsigned* bar, volatile LAS unsigned* st) {
    XcdBarrier b; b.bar = bar; b.x = xb_xcc_id(); b.st = st;
    if (threadIdx.x == 0) (void)xb_add(&bar[XB_XCNT(b.x)], 1u);
    return b;
}
__device__ __forceinline__ void xcd_barrier_complete(unsigned* bar, unsigned x, unsigned& nloc, unsigned& nx) {
    const unsigned G = gridDim.x * gridDim.y * gridDim.z;
    unsigned sum, cnt, mine, sp = 0u;
    for (;;) {
        sum = 0u; cnt = 0u; mine = 0u;
#pragma unroll
        for (unsigned j = 0; j < 16; ++j) { const unsigned c = xb_ld(&bar[XB_XCNT(j)]); sum += c; cnt += (c > 0u) ? 1u : 0u; mine = (j == x) ? c : mine; }
        if (sum == G) break;
        __builtin_amdgcn_s_sleep(1);
        if ((++sp & 255u) == 0u) { if (xb_ld(&bar[XB_TMO])) break; if (sp > XB_SPIN_CAP) { atomicAdd(&bar[XB_TMO], 1u); break; } }
    }
    nloc = mine > 0u ? mine : 1u; nx = cnt > 0u ? cnt : 1u;
}

__device__ __forceinline__ void xcd_barrier(const XcdBarrier& b) {
    asm volatile("s_waitcnt vmcnt(0)" ::: "memory");
    __syncthreads();
    if (threadIdx.x == 0) {
        unsigned* bar = b.bar;
        __builtin_amdgcn_s_waitcnt(0);
        unsigned nloc = b.st[0], nx = b.st[1];
        if (nloc == 0u) { xcd_barrier_complete(bar, b.x, nloc, nx); b.st[0] = nloc; b.st[1] = nx; }
        const unsigned old = xb_add(&bar[XB_XSUB(b.x)], 1u);
        const unsigned gen = old / nloc;
        if (old + 1u == (gen + 1u) * nloc) {
            __builtin_amdgcn_fence(__ATOMIC_RELEASE, "agent");
            asm volatile("s_waitcnt vmcnt(0)" ::: "memory");
            const unsigned og = xb_add(&bar[XB_TOP], 1u);
            const unsigned tg = og / nx;
            if (og + 1u == (tg + 1u) * nx) xb_add(&bar[XB_TOPGEN], 1u);
            else XB_SPIN(xb_ld(&bar[XB_TOPGEN]) == tg, bar);
            __builtin_amdgcn_fence(__ATOMIC_ACQUIRE, "agent");
            xb_add(&bar[XB_XGEN(b.x)], 1u);
            asm volatile("s_waitcnt vmcnt(0)" ::: "memory");
        } else {
            XB_SPIN(xb_ld(&bar[XB_XGEN(b.x)]) == gen, bar);
            __builtin_amdgcn_fence(__ATOMIC_ACQUIRE, "agent");
            asm volatile("s_waitcnt vmcnt(0)" ::: "memory");
        }
    }
    __syncthreads();
}
__device__ __forceinline__ void xcd_local_sync(const XcdBarrier& b) {
    asm volatile("" ::: "memory"); __builtin_amdgcn_s_barrier(); asm volatile("" ::: "memory");
    if (threadIdx.x == 0) {
        unsigned* bar = b.bar; unsigned nloc = b.st[0], nx = b.st[1];
        if (nloc == 0u) { xcd_barrier_complete(bar, b.x, nloc, nx); b.st[0] = nloc; b.st[1] = nx; }
        const unsigned old = xb_add(&bar[XB_LSUB(b.x)], 1u), gen = old / nloc;
        if (old + 1u == (gen + 1u) * nloc) xb_add(&bar[XB_LGEN(b.x)], 1u);
        else XB_SPIN(xb_ld(&bar[XB_LGEN(b.x)]) == gen, bar);
    }
    asm volatile("" ::: "memory"); __builtin_amdgcn_s_barrier(); asm volatile("" ::: "memory");
}
struct XcdSyncHook { XcdBarrier b; __device__ __forceinline__ void operator()() const { xcd_local_sync(b); } };
__device__ __forceinline__ float wave_sum(float v) {
#pragma unroll
    for (int o = 1; o < 64; o <<= 1) v += __shfl_xor(v, o);
    return v;
}
__device__ __forceinline__ float gelu_tanh(float x) {
    const float y = 0.7978845608028654f * (x + 0.044715f * x * x * x);
    const float e = __builtin_amdgcn_exp2f(2.885390081777927f * y);
    const float th = 1.0f - 2.0f * __builtin_amdgcn_rcpf(e + 1.0f);
    return 0.5f * x * (1.0f + th);
}
#ifndef MK_NT_COPY
#define MK_NT_COPY 1
#endif
#ifndef MK_WDROP
#define MK_WDROP 0
#endif
__device__ __forceinline__ unsigned f2bfw(float f) { unsigned u = __builtin_bit_cast(unsigned, f); const int sh = 16 + MK_WDROP; return ((u + ((1u << (sh - 1)) - 1u) + ((u >> sh) & 1u)) >> sh) << MK_WDROP; }
__device__ __forceinline__ unsigned pk2w(float lo, float hi) { return MK_WDROP ? (f2bfw(lo) | (f2bfw(hi) << 16)) : pk2(lo, hi); }
template <bool NT = false> __device__ __forceinline__ void p0_transpose_item(const float* W, int Nsrc, int c0, bf16* WT, int K, int r0, int k0, LAS unsigned* scr, int lane) {
    const float* src = W + (size_t)k0 * Nsrc + c0 + lane;
    float v[64];
#pragma unroll
    for (int i = 0; i < 64; ++i) v[i] = __builtin_nontemporal_load(src + (size_t)i * Nsrc);
#pragma unroll
    for (int i = 0; i < 32; ++i) scr[i * 66 + lane] = pk2w(v[2 * i], v[2 * i + 1]);
    LDS_WAIT(); asm volatile("" ::: "memory");
    const int c = lane & 7;
#pragma unroll
    for (int j = 0; j < 8; ++j) { const int n = (lane >> 3) + 8 * j; const LAS unsigned* s = scr + (4 * c) * 66 + n;
        v4u o; o.x = s[0]; o.y = s[66]; o.z = s[132]; o.w = s[198];
        GAS v4u* d = (GAS v4u*)(WT + (size_t)(r0 + n) * K + k0 + 8 * c); if (NT) __builtin_nontemporal_store(o, d); else *d = o; }
    LDS_WAIT(); asm volatile("" ::: "memory");
}
#define TL_LOAD(v, t) do { _Pragma("unroll") for (int i = 0; i < 16; ++i) v[i] = __builtin_nontemporal_load(src + (size_t)((t) * 64 + i) * (size_t)(Nsrc >> 2)); __builtin_amdgcn_sched_barrier(0); } while (0)
#define TL_EMIT(v, t) do { _Pragma("unroll") for (int e = 0; e < 4; ++e) { v4u o0, o1; \
        o0.x = pk2w(v[0][e], v[1][e]); o0.y = pk2w(v[2][e], v[3][e]); o0.z = pk2w(v[4][e], v[5][e]); o0.w = pk2w(v[6][e], v[7][e]); \
        o1.x = pk2w(v[8][e], v[9][e]); o1.y = pk2w(v[10][e], v[11][e]); o1.z = pk2w(v[12][e], v[13][e]); o1.w = pk2w(v[14][e], v[15][e]); \
        LAS v4u* w_ = (LAS v4u*)(scr + (4 * q + e) * 144 + 32 * h); w_[0] = o0; w_[1] = o1; } \
        LDS_WAIT(); asm volatile("" ::: "memory"); \
        _Pragma("unroll") for (int j = 0; j < 8; ++j) { const int n = (lane >> 3) + 8 * j; const v4u o = *(const LAS v4u*)(scr + n * 144 + 16 * (lane & 7)); \
            GAS v4u* d = (GAS v4u*)(WT + (size_t)(r0 + n) * K + k0 + (t) * 64 + 8 * (lane & 7)); if (NTS) __builtin_nontemporal_store(o, d); else *d = o; } \
        LDS_WAIT(); asm volatile("" ::: "memory"); } while (0)
template <int NT, bool NTS> __device__ __forceinline__ void tr_lds(const float* W, int Nsrc, int c0, bf16* WT, int K, int r0, int k0, LAS unsigned char* scr, int lane) {
    const int q = lane & 15, h = lane >> 4;
    const GAS f32x4* src = (const GAS f32x4*)(W + (size_t)(k0 + 16 * h) * Nsrc + c0 + 4 * q);
    f32x4 va[16], vb[16]; TL_LOAD(va, 0);
#pragma unroll
    for (int t = 0; t < NT; t += 2) { if (t + 1 < NT) TL_LOAD(vb, t + 1); TL_EMIT(va, t); if (t + 1 < NT) { if (t + 2 < NT) TL_LOAD(va, t + 2); TL_EMIT(vb, t + 1); } }
}
#undef TL_LOAD
#undef TL_EMIT
__device__ __forceinline__ unsigned q8pack(f32x4 v) {
    unsigned w = 0u;
    w = __builtin_amdgcn_cvt_pk_u8_f32(__builtin_rintf(v.x + 128.0f), 0, w); w = __builtin_amdgcn_cvt_pk_u8_f32(__builtin_rintf(v.y + 128.0f), 1, w);
    w = __builtin_amdgcn_cvt_pk_u8_f32(__builtin_rintf(v.z + 128.0f), 2, w); w = __builtin_amdgcn_cvt_pk_u8_f32(__builtin_rintf(v.w + 128.0f), 3, w);
    return w ^ 0x80808080u;
}
__device__ __forceinline__ void rms_row_to_bf16(const float* xrow, const float* g, bf16* orow, signed char* q8row, float* q8scale, int lane) {
    const GAS f32x4* xr = (const GAS f32x4*)xrow + lane; const GAS f32x4* gr = (const GAS f32x4*)g + lane;
    f32x4 v[16]; float s = 0.f;
#pragma unroll
    for (int j = 0; j < 16; ++j) { v[j] = xr[64 * j]; s += (v[j].x * v[j].x + v[j].y * v[j].y) + (v[j].z * v[j].z + v[j].w * v[j].w); }
    const float rstd = 1.0f / sqrtf(wave_sum(s) * (1.0f / DM) + EPS);
    GAS v2u* o8 = (GAS v2u*)orow + lane; float amax = 0.f;
#pragma unroll
    for (int j = 0; j < 16; ++j) { const f32x4 gv = gr[64 * j]; v[j] = v[j] * rstd * gv; v2u o; o.x = pk2(v[j].x, v[j].y); o.y = pk2(v[j].z, v[j].w); o8[64 * j] = o;
        amax = fmaxf(amax, fmaxf(fmaxf(fabsf(v[j].x), fabsf(v[j].y)), fmaxf(fabsf(v[j].z), fabsf(v[j].w)))); }
    if (q8row) {
#pragma unroll
        for (int o = 1; o < 64; o <<= 1) amax = fmaxf(amax, __shfl_xor(amax, o));
        const float qs = amax > 0.f ? 127.0f / amax : 0.f;
        if (lane == 0) *q8scale = amax * (1.0f / 127.0f);
        GAS unsigned* q4 = (GAS unsigned*)q8row + lane;
#pragma unroll
        for (int j = 0; j < 16; ++j) q4[64 * j] = q8pack(v[j] * qs);
    }
}

#define TR_LOAD(v, t) do { _Pragma("unroll") for (int i = 0; i < 16; ++i) v[i] = __builtin_nontemporal_load(src + (size_t)((t) * 64 + i) * (size_t)(Nsrc >> 2)); __builtin_amdgcn_sched_barrier(0); } while (0)
#define TR_EMIT_BF(v, t) do { _Pragma("unroll") for (int e = 0; e < 4; ++e) { v4u o0, o1; \
        o0.x = pk2w(v[0][e], v[1][e]); o0.y = pk2w(v[2][e], v[3][e]); o0.z = pk2w(v[4][e], v[5][e]); o0.w = pk2w(v[6][e], v[7][e]); \
        o1.x = pk2w(v[8][e], v[9][e]); o1.y = pk2w(v[10][e], v[11][e]); o1.z = pk2w(v[12][e], v[13][e]); o1.w = pk2w(v[14][e], v[15][e]); \
        GAS v4u* d = (GAS v4u*)(dst + (size_t)e * K + (t) * 64); __builtin_nontemporal_store(o0, d); __builtin_nontemporal_store(o1, d + 1); } } while (0)
#define TR_EMIT_I8(v, t) do { _Pragma("unroll") for (int e = 0; e < 4; ++e) { const float sc = qv[e]; v4u o; \
        o.x = q8pack((f32x4){v[0][e] * sc, v[1][e] * sc, v[2][e] * sc, v[3][e] * sc}); o.y = q8pack((f32x4){v[4][e] * sc, v[5][e] * sc, v[6][e] * sc, v[7][e] * sc}); \
        o.z = q8pack((f32x4){v[8][e] * sc, v[9][e] * sc, v[10][e] * sc, v[11][e] * sc}); o.w = q8pack((f32x4){v[12][e] * sc, v[13][e] * sc, v[14][e] * sc, v[15][e] * sc}); \
        { GAS v4u* d_ = (GAS v4u*)(dst + (size_t)e * 4096 + (t) * 64); if (MK_NT_COPY) __builtin_nontemporal_store(o, d_); else *d_ = o; } } } while (0)
#define TR_PIPE(EMIT) do { f32x4 va[16], vb[16]; TR_LOAD(va, 0); \
        _Pragma("unroll") for (int t = 0; t < NT; t += 2) { if (t + 1 < NT) TR_LOAD(vb, t + 1); EMIT(va, t); if (t + 1 < NT) { if (t + 2 < NT) TR_LOAD(va, t + 2); EMIT(vb, t + 1); } } } while (0)
#define TR_PIPE3(EMIT) do { f32x4 va[16], vb[16], vc[16]; TR_LOAD(va, 0); if (1 < NT) TR_LOAD(vb, 1); \
        _Pragma("unroll") for (int t = 0; t < NT; t += 3) { if (t + 2 < NT) TR_LOAD(vc, t + 2); EMIT(va, t); \
            if (t + 1 < NT) { if (t + 3 < NT) TR_LOAD(va, t + 3); EMIT(vb, t + 1); } \
            if (t + 2 < NT) { if (t + 4 < NT) TR_LOAD(vb, t + 4); EMIT(vc, t + 2); } } } while (0)
template <int NT> __device__ __forceinline__ void tr_run(const float* W, int Nsrc, int c0, bf16* WT, int K, int r0, int k0, int lane) {
    const int q = lane & 15, h = lane >> 4;
    const GAS f32x4* src = (const GAS f32x4*)(W + (size_t)(k0 + 16 * h) * Nsrc + c0 + 4 * q);
    bf16* dst = WT + (size_t)(r0 + 4 * q) * K + k0 + 16 * h;
    TR_PIPE(TR_EMIT_BF);
}
template <int NT> __device__ __forceinline__ void q8_run(const float* W, int Nsrc, int c0, signed char* WT8, int r0, int k0, float qs, int lane) {
    const int q = lane & 15, h = lane >> 4;
    f32x4 qv; qv.x = __shfl(qs, 4 * q); qv.y = __shfl(qs, 4 * q + 1); qv.z = __shfl(qs, 4 * q + 2); qv.w = __shfl(qs, 4 * q + 3);
    const GAS f32x4* src = (const GAS f32x4*)(W + (size_t)(k0 + 16 * h) * Nsrc + c0 + 4 * q);
    signed char* dst = WT8 + (size_t)(r0 + 4 * q) * 4096 + k0 + 16 * h;
    TR_PIPE3(TR_EMIT_I8);
}
__device__ __forceinline__ void q8_strip32(const float* W, int Nsrc, int c0, signed char* WT8, float* SB, int r0, LAS unsigned char* slots, LAS float* red, int wave, int lane) {
    const int q = lane & 7, h = lane >> 3;
    const __amdgpu_buffer_rsrc_t rs = __builtin_amdgcn_make_buffer_rsrc((void*)(W + (size_t)(wave * 512) * Nsrc + c0), (short)0, (int)(512u * (unsigned)Nsrc * 4u), 0x00020000);
    const unsigned voff = ((unsigned)(64 * h) * (unsigned)Nsrc + 4u * q) * 4u;
    LAS v4u* sl = (LAS v4u*)slots + lane;
    v4u pkr[4][4]; f32x4 mx = (f32x4){0.f, 0.f, 0.f, 0.f};
#pragma unroll
    for (int t = 0; t < 8; ++t) { f32x4 v[8];
#pragma unroll
        for (int i = 0; i < 8; ++i) v[i] = __builtin_bit_cast(f32x4, __builtin_amdgcn_raw_buffer_load_b128(rs, voff, (t * 8 + i) * Nsrc * 4, 2));
        __builtin_amdgcn_sched_barrier(0);
#pragma unroll
        for (int i = 0; i < 8; ++i) { mx.x = fmaxf(mx.x, fabsf(v[i].x)); mx.y = fmaxf(mx.y, fabsf(v[i].y)); mx.z = fmaxf(mx.z, fabsf(v[i].z)); mx.w = fmaxf(mx.w, fabsf(v[i].w)); }
#pragma unroll
        for (int e = 0; e < 4; ++e) { v4u w; w.x = pg8::cvt_pk_bf16(v[0][e], v[1][e]); w.y = pg8::cvt_pk_bf16(v[2][e], v[3][e]); w.z = pg8::cvt_pk_bf16(v[4][e], v[5][e]); w.w = pg8::cvt_pk_bf16(v[6][e], v[7][e]);
            if (t < 4) sl[64 * (t * 4 + e)] = w; else pkr[e][t - 4] = w; }
        __builtin_amdgcn_sched_barrier(0); }
#pragma unroll
    for (int o = 8; o < 64; o <<= 1) { mx.x = fmaxf(mx.x, __shfl_xor(mx.x, o)); mx.y = fmaxf(mx.y, __shfl_xor(mx.y, o)); mx.z = fmaxf(mx.z, __shfl_xor(mx.z, o)); mx.w = fmaxf(mx.w, __shfl_xor(mx.w, o)); }
    if (lane < 8) *(LAS f32x4*)(red + wave * 32 + 4 * q) = mx;
    __syncthreads();
    f32x4 cm = *(const LAS f32x4*)(red + 4 * q);
#pragma unroll
    for (int w = 1; w < 8; ++w) { const f32x4 r = *(const LAS f32x4*)(red + w * 32 + 4 * q); cm.x = fmaxf(cm.x, r.x); cm.y = fmaxf(cm.y, r.y); cm.z = fmaxf(cm.z, r.z); cm.w = fmaxf(cm.w, r.w); }
    if (wave == 0 && lane < 8) *(GAS f32x4*)(SB + r0 + 4 * q) = cm * (1.0f / 127.0f);
    signed char* dst = WT8 + (size_t)(r0 + 4 * q) * 4096 + wave * 512 + 64 * h;
#define Q8S_PACK(wa, wb) do { v4u o; \
        o.x = q8pack((f32x4){bflo(wa.x), bfhi(wa.x), bflo(wa.y), bfhi(wa.y)} * sc); o.y = q8pack((f32x4){bflo(wa.z), bfhi(wa.z), bflo(wa.w), bfhi(wa.w)} * sc); \
        o.z = q8pack((f32x4){bflo(wb.x), bfhi(wb.x), bflo(wb.y), bfhi(wb.y)} * sc); o.w = q8pack((f32x4){bflo(wb.z), bfhi(wb.z), bflo(wb.w), bfhi(wb.w)} * sc); \
        __builtin_nontemporal_store(o, dp); } while (0)
#pragma unroll
    for (int e = 0; e < 4; ++e) { const float sc = cm[e] > 0.f ? 127.0f / cm[e] : 0.f;
#pragma unroll
        for (int j = 0; j < 4; ++j) { GAS v4u* dp = (GAS v4u*)(dst + (size_t)e * 4096 + 16 * j);
            if (j < 2) { const v4u wa = sl[64 * ((2 * j) * 4 + e)], wb = sl[64 * ((2 * j + 1) * 4 + e)]; Q8S_PACK(wa, wb); }
            else { const v4u wa = pkr[e][2 * (j - 2)], wb = pkr[e][2 * (j - 2) + 1]; Q8S_PACK(wa, wb); } }
        __builtin_amdgcn_sched_barrier(0); }
#undef Q8S_PACK
    __syncthreads();
}
struct Args { const float* in[27]; float* out; unsigned char* ws; int ph_lo, ph_hi; };
__device__ __forceinline__ const float* in_ptr(int i) {
    const __attribute__((address_space(4))) char* ka = (const __attribute__((address_space(4))) char*)__builtin_amdgcn_kernarg_segment_ptr();
    asm volatile("" : "+s"(ka));
    return *(const float* const __attribute__((address_space(4)))*)(ka + 8 * i);
}

typedef float f32x16 __attribute__((ext_vector_type(16)));
__device__ __forceinline__ int ssm_off(int j, int q) { return j * 528 + q * 4; }
template <bool PROMPT>
__device__ __forceinline__ void ssm_tile(LAS unsigned char* wb, LAS float* tot, const bf16* U, bf16* YS, const unsigned char* FRg, const float* LB, const float* SMETA,
                                         const float* st_re, const float* st_im, float* out, int g, int bq, int rowbase, int wave, int lane) {
    const int j = lane & 31, h2 = lane >> 5;
    const __amdgpu_buffer_rsrc_t rsF = __builtin_amdgcn_make_buffer_rsrc((void*)FRg, (short)0, NFRAG * 1024, 0x00020000);
    const __amdgpu_buffer_rsrc_t rsU = __builtin_amdgcn_make_buffer_rsrc((void*)(U + (size_t)rowbase * SSMW + g * 16), (short)0, 256 * SSMW * 2, 0x00020000);
    const unsigned voffF = (unsigned)lane * 16u, voffU = (unsigned)(8 * j * SSMW + 8 * h2) * 2u;
#define SSM_LDF(f) __builtin_bit_cast(bf16x8, __builtin_amdgcn_raw_buffer_load_b128(rsF, voffF, (f) * 1024, 0))
    bf16x8 X[8], WA[16], WB[16];
#pragma unroll
    for (int ks = 0; ks < 8; ++ks) X[ks] = __builtin_bit_cast(bf16x8, __builtin_amdgcn_raw_buffer_load_b128(rsU, voffU, ks * SSMW * 2, 0));
#pragma unroll
    for (int f = 0; f < 16; ++f) WA[f] = SSM_LDF(f);
    __builtin_amdgcn_sched_barrier(0);
    const unsigned pfo = (unsigned)(84 * wave + lane) * 128u;
    unsigned pf = __builtin_amdgcn_raw_buffer_load_b32(rsF, pfo, 0, 0) ^ __builtin_amdgcn_raw_buffer_load_b32(rsF, pfo + 64u * 128u, 0, 0);
    __builtin_amdgcn_sched_barrier(0);
#pragma unroll
    for (int f = 0; f < 16; ++f) WB[f] = SSM_LDF(16 + f);
    __builtin_amdgcn_sched_barrier(0);
#pragma unroll
    for (int qb = 0; qb < 4; ++qb) { f32x16 acc = {};
#pragma unroll
        for (int ks = 0; ks < 8; ++ks) acc = __builtin_amdgcn_mfma_f32_32x32x16_bf16(qb < 2 ? WA[qb * 8 + ks] : WB[(qb - 2) * 8 + ks], X[ks], acc, 0, 0, 0);
#pragma unroll
        for (int c4 = 0; c4 < 4; ++c4) *(LAS f32x4*)(wb + ssm_off(j, 32 * qb + 8 * c4 + 4 * h2)) = (f32x4){acc[4 * c4], acc[4 * c4 + 1], acc[4 * c4 + 2], acc[4 * c4 + 3]};
        __builtin_amdgcn_sched_barrier(0); }
    bf16x8 A0[10];
#pragma unroll
    for (int f = 0; f < 2; ++f) A0[f] = SSM_LDF(32 + f);
#pragma unroll
    for (int f = 0; f < 8; ++f) A0[2 + f] = SSM_LDF(52 + f);
    __builtin_amdgcn_sched_barrier(0);
    LDS_WAIT();
    const int gp = g * 64 + lane;
    float fre[32], fim[32];
#pragma unroll
    for (int jj = 0; jj < 32; ++jj) { fre[jj] = *(LAS float*)(wb + ssm_off(jj, lane)); fim[jj] = *(LAS float*)(wb + ssm_off(jj, 64 + lane)); }
    const float a1r = LB[2 * 8192 + gp], a1i = LB[3 * 8192 + gp];
    if (PROMPT) {
        const float a32r = LB[4 * 8192 + gp], a32i = LB[5 * 8192 + gp];
        float sr = SMETA[gp], si = SMETA[8192 + gp];
        float tr = 0.f, ti = 0.f;
#pragma unroll
        for (int jj = 0; jj < 32; ++jj) { const float nr = a1r * tr - a1i * ti + fre[jj], ni = a1r * ti + a1i * tr + fim[jj]; tr = nr; ti = ni; }
        tot[wave * 128 + lane] = tr; tot[wave * 128 + 64 + lane] = ti;
        __syncthreads();
        for (int w2 = 0; w2 < wave; ++w2) { const float xr = tot[w2 * 128 + lane], xi = tot[w2 * 128 + 64 + lane]; const float nr = a32r * sr - a32i * si + xr, ni = a32r * si + a32i * sr + xi; sr = nr; si = ni; }
        if (wave == 7) { out[OUT_PRE + (size_t)(bq * NG + g) * NST + lane] = a32r * sr - a32i * si + tr; out[OUT_PIM + (size_t)(bq * NG + g) * NST + lane] = a32r * si + a32i * sr + ti; }
#pragma unroll
        for (int jj = 0; jj < 32; ++jj) { *(LAS float*)(wb + ssm_off(jj, lane)) = sr; *(LAS float*)(wb + ssm_off(jj, 64 + lane)) = si;
            const float nr = a1r * sr - a1i * si + fre[jj], ni = a1r * si + a1i * sr + fim[jj]; sr = nr; si = ni; }
    } else {
#pragma unroll
        for (int j0 = 0; j0 < 32; j0 += 8) { float s0r[8], s0i[8];
#pragma unroll
            for (int jj = 0; jj < 8; ++jj) { const size_t so = ((size_t)(bq + j0 + jj) * NG + g) * NST + lane; s0r[jj] = st_re[so]; s0i[jj] = st_im[so]; }
            __builtin_amdgcn_sched_barrier(0);
#pragma unroll
            for (int jj = 0; jj < 8; ++jj) { const size_t so = ((size_t)(bq + j0 + jj) * NG + g) * NST + lane; const float sr = s0r[jj], si = s0i[jj];
                *(LAS float*)(wb + ssm_off(j0 + jj, lane)) = sr; *(LAS float*)(wb + ssm_off(j0 + jj, 64 + lane)) = si;
                out[OUT_SRE + so] = a1r * sr - a1i * si + fre[j0 + jj]; out[OUT_SIM + so] = a1r * si + a1i * sr + fim[j0 + jj]; } }
    }
    LDS_WAIT();
    bf16x8 S[8];
#pragma unroll
    for (int ks = 0; ks < 8; ++ks) { const f32x4 v0 = *(LAS f32x4*)(wb + ssm_off(j, 16 * ks + 8 * h2)), v1 = *(LAS f32x4*)(wb + ssm_off(j, 16 * ks + 8 * h2 + 4));
        S[ks] = __builtin_bit_cast(bf16x8, pg8::pack8(v0, v1)); }
#define SSM_OUT(rb, acc) do { _Pragma("unroll") for (int c4 = 0; c4 < 4; ++c4) { const int t = 2 * (rb) + (c4 >> 1), h0 = 8 * (c4 & 1) + 4 * h2; \
        v2u o; o.x = pg8::cvt_pk_bf16(gelu_tanh(acc[4 * c4]), gelu_tanh(acc[4 * c4 + 1])); o.y = pg8::cvt_pk_bf16(gelu_tanh(acc[4 * c4 + 2]), gelu_tanh(acc[4 * c4 + 3])); \
        *(GAS v2u*)(YS + (size_t)(rowbase + 8 * j + t) * SSMW + g * 16 + h0) = o; } } while (0)
    __builtin_amdgcn_sched_barrier(0);
    { bf16x8 A1[12];
#pragma unroll
      for (int f = 0; f < 4; ++f) A1[f] = SSM_LDF(34 + f);
#pragma unroll
      for (int f = 0; f < 8; ++f) A1[4 + f] = SSM_LDF(60 + f);
      __builtin_amdgcn_sched_barrier(0);
      f32x16 acc = {};
#pragma unroll
      for (int ks = 0; ks < 2; ++ks) acc = __builtin_amdgcn_mfma_f32_32x32x16_bf16(A0[ks], X[ks], acc, 0, 0, 0);
#pragma unroll
      for (int ks = 0; ks < 8; ++ks) acc = __builtin_amdgcn_mfma_f32_32x32x16_bf16(A0[2 + ks], S[ks], acc, 0, 0, 0);
      __builtin_amdgcn_sched_barrier(0);
      bf16x8 A2[14];
#pragma unroll
      for (int f = 0; f < 6; ++f) A2[f] = SSM_LDF(38 + f);
#pragma unroll
      for (int f = 0; f < 8; ++f) A2[6 + f] = SSM_LDF(68 + f);
      __builtin_amdgcn_sched_barrier(0);
      SSM_OUT(0, acc);
      __builtin_amdgcn_sched_barrier(0);
      f32x16 acc1 = {};
#pragma unroll
      for (int ks = 0; ks < 4; ++ks) acc1 = __builtin_amdgcn_mfma_f32_32x32x16_bf16(A1[ks], X[ks], acc1, 0, 0, 0);
#pragma unroll
      for (int ks = 0; ks < 8; ++ks) acc1 = __builtin_amdgcn_mfma_f32_32x32x16_bf16(A1[4 + ks], S[ks], acc1, 0, 0, 0);
      __builtin_amdgcn_sched_barrier(0);
      bf16x8 A3[16];
#pragma unroll
      for (int f = 0; f < 8; ++f) A3[f] = SSM_LDF(44 + f);
#pragma unroll
      for (int f = 0; f < 8; ++f) A3[8 + f] = SSM_LDF(76 + f);
      __builtin_amdgcn_sched_barrier(0);
      SSM_OUT(1, acc1);
      __builtin_amdgcn_sched_barrier(0);
      f32x16 acc2 = {};
#pragma unroll
      for (int ks = 0; ks < 6; ++ks) acc2 = __builtin_amdgcn_mfma_f32_32x32x16_bf16(A2[ks], X[ks], acc2, 0, 0, 0);
#pragma unroll
      for (int ks = 0; ks < 8; ++ks) acc2 = __builtin_amdgcn_mfma_f32_32x32x16_bf16(A2[6 + ks], S[ks], acc2, 0, 0, 0);
      SSM_OUT(2, acc2);
      __builtin_amdgcn_sched_barrier(0);
      f32x16 acc3 = {};
#pragma unroll
      for (int ks = 0; ks < 8; ++ks) acc3 = __builtin_amdgcn_mfma_f32_32x32x16_bf16(A3[ks], X[ks], acc3, 0, 0, 0);
#pragma unroll
      for (int ks = 0; ks < 8; ++ks) acc3 = __builtin_amdgcn_mfma_f32_32x32x16_bf16(A3[8 + ks], S[ks], acc3, 0, 0, 0);
      SSM_OUT(3, acc3); }
#undef SSM_OUT
#undef SSM_LDF
    asm volatile("" :: "v"(pf));
}

__global__ void __launch_bounds__(NWAVES * 64, 2) fwd(Args args) {
    extern __shared__ __attribute__((aligned(16))) unsigned char lds_raw[];
    LAS unsigned char* lds = (LAS unsigned char*)lds_raw;
    volatile LAS unsigned* MISC = (volatile LAS unsigned*)(lds + MISC_OFF);
    const int tid = threadIdx.x, lane = tid & 63, wave = __builtin_amdgcn_readfirstlane(tid >> 6);
    const int G = gridDim.x; const int bx = blockIdx.x; const int vcu = (G % 8 == 0) ? (bx % 8) * (G / 8) + bx / 8 : bx;
    const int gw = vcu * NWAVES + wave, NGW = G * NWAVES;
    unsigned char* ws = args.ws;
    unsigned* ctl = (unsigned*)(ws + WS_CTL);
    float* out = args.out;
    float* LB = (float*)(ws + WS_LB); float* BB = (float*)(ws + WS_BB); float* PM = (float*)(ws + WS_PM); bf16* HNM = (bf16*)(ws + WS_HNM);
    float* SMETA = (float*)(ws + WS_SMETA);
    bf16* WT_IN = (bf16*)(ws + WS_WIN); bf16* WT_GLU = (bf16*)(ws + WS_WGLU); bf16* WT_CO = (bf16*)(ws + WS_WCO); bf16* WT_O = (bf16*)(ws + WS_WO); bf16* WT_UP = (bf16*)(ws + WS_WUP); bf16* WT_DN = (bf16*)(ws + WS_WDN);
    bf16* HN = (bf16*)(ws + WS_R0); bf16* YS = (bf16*)(ws + WS_R0); bf16* YC = (bf16*)(ws + WS_R0 + A36); bf16* HF = (bf16*)(ws + WS_R0);
    bf16* U = (bf16*)(ws + WS_R1); bf16* Z = (bf16*)(ws + WS_R1 + A36); bf16* M1 = (bf16*)(ws + WS_R6 + A72);
    bf16* CB = (bf16*)(ws + WS_R2); bf16* SGA = (bf16*)(ws + WS_R3); bf16* SGB = (bf16*)(ws + WS_R4); bf16* MG = (bf16*)(ws + WS_R5);
    signed char* HN8 = (signed char*)(ws + WS_R5); signed char* WT_IN8 = (signed char*)(ws + WS_WIN + (size_t)64 * MiB); float* SAH = (float*)(ws + WS_SS1 + 131072); float* SBIN = (float*)(ws + WS_SS2 + 131072); signed char* HF8 = (signed char*)(ws + WS_R0); signed char* WT_UP8 = (signed char*)(ws + WS_WUP); float* SA = (float*)(ws + WS_SS1 + 65536); float* SB = (float*)(ws + WS_SS2);      bf16* OB = (bf16*)(ws + WS_R6); bf16* FB = (bf16*)(ws + WS_R6 + A72); bf16* GS = (bf16*)(ws + WS_WIN + (size_t)64 * MiB);   bf16* XT = (bf16*)(ws + WS_WIN);   float* RS1 = (float*)(ws + WS_SS1); bf16* HB = (bf16*)(ws + WS_H);

    for (int u = tid; u < 64; u += NWAVES * 64) MISC[u] = 0u;
    __syncthreads();
    XcdBarrier bar; bar.bar = ctl + CW_BAR; bar.x = 0; bar.st = nullptr;
    if (N_LAUNCHES != N_PHASES) bar = xcd_barrier_post(ctl + CW_BAR, MISC + 8);
#define GRID_BAR() do { if (N_LAUNCHES != N_PHASES) xcd_barrier(bar); } while (0)
    const int lo = args.ph_lo, hi = args.ph_hi;
#define IN(k) (lo <= (k) && (k) < hi)
#define BOTH(k) (IN(k) && IN((k) + 1))
#define ROW_LOOP(m, LIMIT, EXTRA) for (int k_ = 0, m = gw; k_ < 5; ++k_, m = (k_ < 4 ? gw + k_ * NGW : (G == 256 ? (wave < 4 ? MP + vcu * 4 + wave : (wave == 7 ? (EXTRA) : (LIMIT))) : gw + 4 * NGW))) if (m < (LIMIT))

    if (IN(0)) {
        const float* x_prompt = in_ptr(0); const float* x_sample = in_ptr(1); const float* meta = in_ptr(5); const float* g_pre_mix = in_ptr(6); const float* w_in = in_ptr(7);
        const float* lam_re = in_ptr(8); const float* lam_im = in_ptr(9); const float* log_dt = in_ptr(10); const float* b_re = in_ptr(11); const float* b_im = in_ptr(12);
        const float* c_re = in_ptr(13); const float* c_im = in_ptr(14); const float* ssm_d = in_ptr(15); const float* w_glu_v = in_ptr(16); const float* w_glu_g = in_ptr(17);
        const float* w_conv_out = in_ptr(19); const float* w_o = in_ptr(20); const float* w_ffn_gate = in_ptr(23); const float* w_ffn_up = in_ptr(24); const float* w_ffn_down = in_ptr(25);
        for (int g = bx; g < NG; g += G) {
            LAS float* LPR = (LAS float*)(lds + RING_OFF); LAS float* LPI = LPR + 9 * 64; LAS float* BR = LPI + 9 * 64; LAS float* BI = BR + 1024;
            LAS float* CR = BI + 1024; LAS float* CI = CR + 1024; LAS float* MT = CI + 1024; LAS float* DD = MT + 2048;
            { const double dt = exp((double)log_dt[g]);
              for (int e = tid; e < 10 * 64; e += NWAVES * 64) {
                const int p = e & 63, dsel = e >> 6, idx = g * 64 + p; const double dd = dsel < 9 ? (double)dsel : 256.0;
                const double a = (double)lam_re[idx] * dt * dd, b = (double)lam_im[idx] * dt * dd, ea = exp(a); const float vr = (float)(ea * cos(b)), vi = (float)(ea * sin(b));
                if (dsel < 9) { LPR[dsel * 64 + p] = vr; LPI[dsel * 64 + p] = vi; }
                if (dsel == 1) { LB[idx] = vr; LB[8192 + idx] = vi; } else if (dsel == 8) { LB[2 * 8192 + idx] = vr; LB[3 * 8192 + idx] = vi; } else if (dsel == 9) { LB[4 * 8192 + idx] = vr; LB[5 * 8192 + idx] = vi; } }
              if (tid >= 128 && tid < 192) {
                const int p = tid - 128, idx = g * 64 + p; const double lr = (double)lam_re[idx], li = (double)lam_im[idx];
                const double a = lr * dt, b = li * dt, ea = exp(a), sb = sin(b), cb = cos(b);
                const double sh = sin(0.5 * b), nr = expm1(a) * cb - 2.0 * sh * sh, ni = ea * sb;
                const double inv = 1.0 / (lr * lr + li * li), qr = (nr * lr + ni * li) * inv, qi = (ni * lr - nr * li) * inv;
                for (int h = 0; h < 16; ++h) { const double br = (double)b_re[idx * 16 + h], bi = (double)b_im[idx * 16 + h];
                    const float vr = (float)(qr * br - qi * bi), vi = (float)(qr * bi + qi * br);
                    BB[idx * 16 + h] = vr; BB[131072 + idx * 16 + h] = vi; BR[p * 16 + h] = vr; BI[p * 16 + h] = vi; } } }
            for (int i = tid; i < 1024; i += NWAVES * 64) { CR[i] = c_re[g * 1024 + i]; CI[i] = c_im[g * 1024 + i]; }
            if (tid < 16) DD[tid] = ssm_d[g * 16 + tid];
            __syncthreads();
            for (int e = tid; e < 2048; e += NWAVES * 64) { const int d = e >> 8, h = (e >> 4) & 15, hp = e & 15; float sacc = 0.f;
                for (int p = 0; p < 64; ++p) { const float cr = CR[h * 64 + p], ci = CI[h * 64 + p], lr = LPR[d * 64 + p], li = LPI[d * 64 + p];
                    const float tr = cr * lr - ci * li, ti = cr * li + ci * lr; sacc += tr * BR[p * 16 + hp] - ti * BI[p * 16 + hp]; }
                MT[e] = sacc; }
            __syncthreads();
            unsigned char* FRg = ws + WS_FR + (size_t)g * NFRAG * 1024;
            for (int pr = tid; pr < NFRAG * 64; pr += NWAVES * 64) {
                const int f = pr >> 6, l = pr & 63, row = l & 31, kb = 8 * (l >> 5); float v[8];
                if (f < 32) { const int qb = f >> 3, ks = f & 7, q = 32 * qb + row, p = q & 63;
#pragma unroll
                    for (int i = 0; i < 8; ++i) { const float lr = LPR[(7 - ks) * 64 + p], li = LPI[(7 - ks) * 64 + p], br = BR[p * 16 + kb + i], bi = BI[p * 16 + kb + i];
                        v[i] = (q < 64) ? (lr * br - li * bi) : (lr * bi + li * br); }
                } else if (f < 52) { const int ft = f - 32, rb = ft < 2 ? 0 : (ft < 6 ? 1 : (ft < 12 ? 2 : 3)), ks = ft - rb * (rb + 1), t = 2 * rb + (row >> 4), h = row & 15;
#pragma unroll
                    for (int i = 0; i < 8; ++i) { const int hp = kb + i; float x = 0.f; if (t >= ks) { x = MT[((t - ks) << 8) + (h << 4) + hp]; if (t == ks && h == hp) x += DD[h]; } v[i] = x; }
                } else { const int fg = f - 52, rb = fg >> 3, ks = fg & 7, t = 2 * rb + (row >> 4), h = row & 15;
#pragma unroll
                    for (int i = 0; i < 8; ++i) { const int q = 16 * ks + kb + i, p = q & 63; const float cr = CR[h * 64 + p], ci = CI[h * 64 + p], lr = LPR[(t + 1) * 64 + p], li = LPI[(t + 1) * 64 + p];
                        v[i] = (q < 64) ? (cr * lr - ci * li) : -(cr * li + ci * lr); }
                }
                v4u o; o.x = pk2(v[0], v[1]); o.y = pk2(v[2], v[3]); o.z = pk2(v[4], v[5]); o.w = pk2(v[6], v[7]);
                *(GAS v4u*)(FRg + (size_t)pr * 16) = o;
            }
            __syncthreads();
        }
        LAS unsigned* scr = (LAS unsigned*)(lds + RING_OFF + wave * 16384);
        for (int st = bx; st < (2 * DM) / 32; st += G)
            q8_strip32(w_in, INCOLS, 8192 + 32 * st, WT_IN8, SBIN, 32 * st, lds + RING_OFF + wave * 16384, (LAS float*)(lds + TOT_OFF), wave, lane);
        constexpr int I_IN = (DM / 256) * (8192 / 64);
        for (int it = gw; it < I_IN; it += NGW) {
            const int nblk = 8192 / 64, kb = it / nblk, nb = it % nblk, r0 = nb * 64; int c0;
            if (r0 < 2048) c0 = r0;
            else if (r0 < 6144) { const int q = r0 - 2048; c0 = (((q >> 7) & 1) ? 6144 : 2048) + 128 * (q >> 8) + (q & 127); }
            else c0 = 4096 + (r0 - 6144);
            tr_lds<4, false>(w_in, INCOLS, c0, WT_IN, DM, r0, kb * 256, lds + RING_OFF + wave * 16384, lane);
        }
        ROW_LOOP(m, M + NMETA, vcu < NMETA ? M + vcu : M + NMETA) {
            const float* xr = m < MP ? x_prompt + (size_t)m * DM : (m < M ? x_sample + (size_t)(m - MP) * DM : meta + (size_t)(m - M) * DM);
            bf16* orow = m < M ? HN + (size_t)m * DM : HNM + (size_t)(m - M) * DM;
            rms_row_to_bf16(xr, g_pre_mix, orow, m < M ? HN8 + (size_t)m * DM : nullptr, SAH + (m < M ? m : 0), lane);
        }
        if (BOTH(0)) GRID_BAR();
    }

    if (IN(1)) {
      const int GG = G - NCONV;
      if (NCONV == 0 || bx >= GG) {
        const int cw0 = NCONV ? (bx - GG) * NWAVES + wave : gw, cwn = NCONV ? NCONV * NWAVES : NGW;
        const float* w_glu_v = in_ptr(16); const float* w_glu_g = in_ptr(17); const float* w_conv_out = in_ptr(19); const float* w_o = in_ptr(20);
        const float* w_ffn_gate = in_ptr(23); const float* w_ffn_up = in_ptr(24); const float* w_ffn_down = in_ptr(25);
#ifdef MK_PROBE_C2
        for (int rep = 0; rep < 2; ++rep) {
#endif
        for (int st = vcu; st < 2 * DFF / 32; st += G) { const int r0 = st * 32;
            q8_strip32(((r0 >> 7) & 1) ? w_ffn_up : w_ffn_gate, DFF, 128 * (r0 >> 8) + (r0 & 127), WT_UP8, SB, r0, lds + RING_OFF + wave * 16384, (LAS float*)(lds + TOT_OFF), wave, lane); }
        constexpr int I_UP = 0, I_GLU = (SSMW / 256) * (2 * DM / 64), I_CO = (CONVW / 256) * (DM / 64), I_O = (DM / 256) * (DM / 64);
        constexpr int I_DN = (DFF / 128) * (DM / 64), NITEMS = I_UP + I_GLU + I_CO + I_O + I_DN;
        constexpr int NSTRIP = 2 * DFF / 32, NX = (NCONV == 0) ? (256 - (NSTRIP - 2 * 256)) * NWAVES : 0, NY = (NCONV == 0) ? 128 * 5 : 0;
        const bool bal = (NCONV == 0) && G == 256;
        const int na = (bal && vcu >= NSTRIP - 2 * 256) ? 1 : 0, nb = (bal && bx < 128 && wave < 5) ? 1 : 0;
        const int nx = bal ? NX : 0, ny = bal ? NY : 0;
        for (int n = 0;; ++n) {
            const int it = n < na ? (vcu - (NSTRIP - 2 * 256)) * NWAVES + wave : (n < na + nb ? nx + bx * 5 + wave : nx + ny + cw0 + (n - na - nb) * cwn);
            if (it >= NITEMS) break;
            int r = it;
            if (r < I_GLU) { const int nblk = 2 * DM / 64, kb = r / nblk, nb = r % nblk, r0 = nb * 64; const int c0 = 128 * (r0 >> 8) + (r0 & 127);
                tr_lds<4, MK_NT_COPY != 0>(((r0 >> 7) & 1) ? w_glu_g : w_glu_v, DM, c0, WT_GLU, SSMW, r0, kb * 256, lds + RING_OFF + wave * 16384, lane); continue; } r -= I_GLU;
            if (r < I_CO) { const int nblk = DM / 64, kb = r / nblk, nb = r % nblk; tr_lds<4, MK_NT_COPY != 0>(w_conv_out, DM, nb * 64, WT_CO, CONVW, nb * 64, kb * 256, lds + RING_OFF + wave * 16384, lane); continue; } r -= I_CO;
            if (r < I_O) { const int nblk = DM / 64, kb = r / nblk, nb = r % nblk; tr_lds<4, MK_NT_COPY != 0>(w_o, DM, nb * 64, WT_O, DM, nb * 64, kb * 256, lds + RING_OFF + wave * 16384, lane); continue; } r -= I_O;
            { const int nblk = DM / 64, kb = r / nblk, nb = r % nblk; tr_lds<2, MK_NT_COPY != 0>(w_ffn_down, DM, nb * 64, WT_DN, DFF, nb * 64, kb * 128, lds + RING_OFF + wave * 16384, lane); }
        }
#ifdef MK_PROBE_C2
        }
#endif
      }
      if (NCONV == 0) __syncthreads();
      if (NCONV == 0 || bx < GG) {
        LAS float* red = (LAS float*)(lds + RING_OFF);
        for (int t = bx; t < NMETACOLS / 16; t += GG) {
            const int n0 = t * 16, kbase = wave * 512;
            const bf16* ap = HNM + (size_t)(lane & 15) * DM + kbase + 8 * (lane >> 4);
            const bf16* bp = WT_IN + (size_t)(n0 + (lane & 15)) * DM + kbase + 8 * (lane >> 4);
            f32x4 acc = (f32x4){0.f, 0.f, 0.f, 0.f};
#pragma unroll 4
            for (int k = 0; k < 512; k += 32) { const bf16x8 af = *(const GAS bf16x8*)(ap + k), bf = *(const GAS bf16x8*)(bp + k);
                acc = __builtin_amdgcn_mfma_f32_16x16x32_bf16(af, bf, acc, 0, 0, 0); }
#pragma unroll
            for (int r = 0; r < 4; ++r) red[(wave * 4 + r) * 64 + lane] = acc[r];
            __syncthreads();
            LAS float* pmt = red + 2048;
            if (tid < 256) { const int r = tid >> 6; float s = 0.f;
#pragma unroll
                for (int w = 0; w < 8; ++w) s += red[(w * 4 + r) * 64 + lane];
                PM[(size_t)(4 * (lane >> 4) + r) * NMETACOLS + n0 + (lane & 15)] = s; pmt[(4 * (lane >> 4) + r) * 16 + (lane & 15)] = s; }
            __syncthreads();
            if (t < NG && wave == 0) {
                const int gp = t * 64 + lane; const float lbr = LB[gp], lbi = LB[8192 + gp]; float bbr[16], bbi[16], sr = 0.f, si = 0.f;
#pragma unroll
                for (int h = 0; h < 16; ++h) { bbr[h] = BB[gp * 16 + h]; bbi[h] = BB[131072 + gp * 16 + h]; }
                for (int tau = 0; tau < NMETA; ++tau) { float br = 0.f, bi = 0.f;
#pragma unroll
                    for (int h = 0; h < 16; ++h) { const float uu = pmt[tau * 16 + h]; br = fmaf(bbr[h], uu, br); bi = fmaf(bbi[h], uu, bi); }
                    const float nr = lbr * sr - lbi * si + br, ni = lbr * si + lbi * sr + bi; sr = nr; si = ni; }
                SMETA[gp] = sr; SMETA[8192 + gp] = si;
            }
        }
        __syncthreads();
#ifdef MK_PROBE_G2
        for (int rep = 0; rep < 2; ++rep) {
#endif
        { pg8::Gemm g{(const bf16*)HN8, (const bf16*)WT_IN8, M, 8192, DM / 2}; typedef pg8::StaticOrderT<M, 8192, DM / 2> SO; SO S; S.init(GG, bx);
          pg8::EpiGateI8 E{SGA, SGB, SAH, SBIN};
          pg8::gemm_phase<pg8::EpiGateI8, SO, true, true, pg8::NoHook, true>(lds + RING_OFF, g, S, E); }
        { pg8::Gemm g{HN, WT_IN, M, 8192, DM}; typedef pg8::StaticOrderT<M, 8192, DM> SO; SO S; S.init(GG, NCONV ? bx : (bx + G / 2) % G);
          pg8::EpiProj E{U, Z, CB, SGA, SGB};
          pg8::gemm_phase<pg8::EpiProj, SO, true, true>(lds + RING_OFF, g, S, E); }
#ifdef MK_PROBE_G2
        }
#endif
      }
        if (BOTH(1)) GRID_BAR();
    }

    if (IN(2)) {
        const float* st_re = in_ptr(2); const float* st_im = in_ptr(3);
        {
            LAS unsigned char* wb = lds + RING_OFF + wave * SSM_WB; int par = 0;
            for (int it = bx; it < NBATCH * NG; it += G) {
                const int g = __builtin_amdgcn_readfirstlane(G == 256 ? 64 * ((bx >> 2) & 1) + 32 * (it >> 8) + (bx >> 3) : it >> 2), b = __builtin_amdgcn_readfirstlane(it & 3);
                unsigned pfn = 0u;
                if (G == 256 && it + G < NBATCH * NG) { const unsigned char* fr2 = ws + WS_FR + (size_t)(g + 32) * NFRAG * 1024; const unsigned l0 = (unsigned)(84 * wave + lane) * 128u;
                    pfn = *(const GAS unsigned*)(fr2 + l0) ^ (lane < 20 ? *(const GAS unsigned*)(fr2 + l0 + 64u * 128u) : 0u);
                    const bf16* u2 = U + (size_t)(b * SEQ + 256 * wave + lane) * SSMW + (g + 32) * 16;
#pragma unroll
                    for (int i = 0; i < 4; ++i) pfn ^= *(const GAS unsigned*)(u2 + (size_t)(64 * i) * SSMW); }
                ssm_tile<true>(wb, (LAS float*)(lds + TOT_OFF + par * 4096), U, YS, ws + WS_FR + (size_t)g * NFRAG * 1024, LB, SMETA, st_re, st_im, out, g, b, b * SEQ + 256 * wave, wave, lane);
                asm volatile("" :: "v"(pfn));
                par ^= 1; }
            for (int it = bx; it < NG / 2; it += G) {
                const int g = __builtin_amdgcn_readfirstlane(2 * it + (wave >> 2)), tile = wave & 3;
                ssm_tile<false>(wb, (LAS float*)(lds + TOT_OFF), U, YS, ws + WS_FR + (size_t)g * NFRAG * 1024, LB, SMETA, st_re, st_im, out, g, 32 * tile, MP + 256 * tile, wave, lane); }
            if (bx >= NG / 2) {
                const float* st_cv = in_ptr(4); const float* conv_w = in_ptr(18);
            const int nthr = (G - NG / 2) * NWAVES * 64, t0 = ((bx - NG / 2) * NWAVES + wave) * 64 + lane;
            for (int it = t0; it < M * (CONVW / 8); it += nthr) {
                const int row = it >> 8, c = (it & 255) * 8;
                float z1[8], z2[8];
                const v4u z0w = *(const GAS v4u*)(Z + (size_t)row * CONVW + c), cbw = *(const GAS v4u*)(CB + (size_t)row * CONVW + c);
                int t; const float* sv1 = nullptr; const float* sv2 = nullptr; int m1 = -1, m2 = -1;
                if (row < MP) { t = row & (SEQ - 1); if (t < 1) m1 = 15; if (t < 2) m2 = 14 + t; }
                else { const int sI = row - MP, b = sI >> 3; t = sI & 7; if (t < 1) sv1 = st_cv + (size_t)(b * 2 + 1) * CONVW + c; if (t < 2) sv2 = st_cv + (size_t)(b * 2 + t) * CONVW + c; }
                if (t >= 1) { const v4u w = *(const GAS v4u*)(Z + (size_t)(row - 1) * CONVW + c); z1[0] = bflo(w.x); z1[1] = bfhi(w.x); z1[2] = bflo(w.y); z1[3] = bfhi(w.y); z1[4] = bflo(w.z); z1[5] = bfhi(w.z); z1[6] = bflo(w.w); z1[7] = bfhi(w.w); }
                else if (sv1) {
#pragma unroll
                    for (int e = 0; e < 8; ++e) z1[e] = sv1[e]; }
                else {
#pragma unroll
                    for (int e = 0; e < 8; ++e) { const int cc = c + e, q = 2048 + (cc >> 7) * 256 + (cc & 127); z1[e] = PM[(size_t)m1 * NMETACOLS + q] * PM[(size_t)m1 * NMETACOLS + q + 128]; } }
                if (t >= 2) { const v4u w = *(const GAS v4u*)(Z + (size_t)(row - 2) * CONVW + c); z2[0] = bflo(w.x); z2[1] = bfhi(w.x); z2[2] = bflo(w.y); z2[3] = bfhi(w.y); z2[4] = bflo(w.z); z2[5] = bfhi(w.z); z2[6] = bflo(w.w); z2[7] = bfhi(w.w); }
                else if (sv2) {
#pragma unroll
                    for (int e = 0; e < 8; ++e) z2[e] = sv2[e]; }
                else {
#pragma unroll
                    for (int e = 0; e < 8; ++e) { const int cc = c + e, q = 2048 + (cc >> 7) * 256 + (cc & 127); z2[e] = PM[(size_t)m2 * NMETACOLS + q] * PM[(size_t)m2 * NMETACOLS + q + 128]; } }
                const float z0[8] = {bflo(z0w.x), bfhi(z0w.x), bflo(z0w.y), bfhi(z0w.y), bflo(z0w.z), bfhi(z0w.z), bflo(z0w.w), bfhi(z0w.w)};
                const float cbv[8] = {bflo(cbw.x), bfhi(cbw.x), bflo(cbw.y), bfhi(cbw.y), bflo(cbw.z), bfhi(cbw.z), bflo(cbw.w), bfhi(cbw.w)};
                float y[8];
#pragma unroll
                for (int e = 0; e < 8; ++e) y[e] = cbv[e] * (conv_w[c + e] * z2[e] + conv_w[CONVW + c + e] * z1[e] + conv_w[2 * CONVW + c + e] * z0[e]);
                v4u o; o.x = pk2(y[0], y[1]); o.y = pk2(y[2], y[3]); o.z = pk2(y[4], y[5]); o.w = pk2(y[6], y[7]);
                *(GAS v4u*)(YC + (size_t)row * CONVW + c) = o;
            }
            for (int it = t0; it < (NBATCH + DBATCH) * 2 * CONVW; it += nthr) {
                const int c = it & (CONVW - 1), k = (it >> 11) & 1, sq = it >> 12;
                if (sq < NBATCH) out[OUT_PCV + (size_t)(sq * 2 + k) * CONVW + c] = bf1(Z[(size_t)(sq * SEQ + SEQ - 2 + k) * CONVW + c]);
                else { const int b = sq - NBATCH; out[OUT_SCV + (size_t)(b * 2 + k) * CONVW + c] = bf1(Z[(size_t)(MP + b * DSEQ + DSEQ - 2 + k) * CONVW + c]); }
            }
            }
        }
        if (BOTH(2)) GRID_BAR();
    }

    if (IN(3)) {
        pg8::Gemm g{YC, WT_CO, M, DM, CONVW}; typedef pg8::TailSplitOrderT<MP, M, DM, CONVW, 4> SO; SO S; S.init(G, bx);
        pg8::EpiBf16Parts E{M1, XT, MP, MSMP};
        pg8::gemm_phase<pg8::EpiBf16Parts, SO, true, true>(lds + RING_OFF, g, S, E);
        if (BOTH(3)) GRID_BAR();
    }
    if (IN(4)) {
        pg8::Gemm g{YS, WT_GLU, M, 2 * DM, SSMW}; typedef pg8::TailSplitOrderT<MP, M, 2 * DM, SSMW, 2> SO; SO S; S.init(G, bx);
        pg8::EpiGluMerge E{SGA, SGB, M1, GS, MG, MP, MSMP};
        pg8::gemm_phase<pg8::EpiGluMerge, SO, true, true>(lds + RING_OFF, g, S, E);
        if (BOTH(4)) GRID_BAR();
    }
    if (IN(5)) {
        for (int it = gw; it < 2 * MSMP; it += NGW) {
            const int r = it >> 1, cbase = (it & 1) * 2048; const size_t ro = (size_t)(MP + r) * DM + cbase;
            const GAS v4u* xp = (const GAS v4u*)(XT + (size_t)r * DM + cbase) + lane;
            const GAS v2u* sa = (const GAS v2u*)((const GAS unsigned char*)SGA + ro) + lane; const GAS v2u* sg = (const GAS v2u*)((const GAS unsigned char*)SGB + ro) + lane; GAS v4u* mg = (GAS v4u*)(MG + ro) + lane;
#pragma unroll
            for (int j = 0; j < 4; ++j) {
                const int c = cbase + 512 * j + 8 * lane; const GAS v4u* gp = (const GAS v4u*)(GS + (size_t)r * 8192 + 256 * (c >> 7) + (c & 127));
                f32x4 v0, v1, g0, g1, t0, t1, a0, a1;
                pg8::unpack8(gp[0], v0, v1); pg8::unpack8(gp[(size_t)MSMP * 8192 / 8], t0, t1); v0 = v0 + t0; v1 = v1 + t1;
                pg8::unpack8(gp[16], g0, g1); pg8::unpack8(gp[16 + (size_t)MSMP * 8192 / 8], t0, t1); g0 = g0 + t0; g1 = g1 + t1;
                pg8::unpack8(xp[64 * j], a0, a1);
#pragma unroll
                for (int p = 1; p < 4; ++p) { pg8::unpack8(xp[64 * j + (size_t)p * MSMP * DM / 8], t0, t1); a0 = a0 + t0; a1 = a1 + t1; }
                f32x4 s0, s1, b0, b1; { const v2u w = sa[64 * j]; pg8::u32x2 w2; w2.x = w.x; w2.y = w.y; pg8::unpack8u(w2, s0, s1); } { const v2u w = sg[64 * j]; pg8::u32x2 w2; w2.x = w.x; w2.y = w.y; pg8::unpack8u(w2, b0, b1); }
                mg[64 * j] = pg8::pack8(s0 * v0 * pg8::sigm4(g0) + b0 * a0, s1 * v1 * pg8::sigm4(g1) + b1 * a1); }
        }
        if (BOTH(5)) GRID_BAR();
    }
    if (IN(6)) {
        pg8::Gemm g{MG, WT_O, M, DM, DM}; typedef pg8::TailSplitOrderT<MP, M, DM, DM, 4> SO; SO S; S.init(G, bx);
        pg8::EpiBf16Parts E{OB, XT, MP, MSMP};
        pg8::gemm_phase<pg8::EpiBf16Parts, SO, true, true>(lds + RING_OFF, g, S, E);
        if (BOTH(6)) GRID_BAR();
    }
    if (IN(7)) {
        const float* x_prompt = in_ptr(0); const float* x_sample = in_ptr(1); const float* g_post_mix = in_ptr(21); const float* g_pre_ffn = in_ptr(22);
        ROW_LOOP(m, M, M) {
            const GAS f32x4* xr = (const GAS f32x4*)(m < MP ? x_prompt + (size_t)m * DM : x_sample + (size_t)(m - MP) * DM) + 2 * lane;
            const GAS f32x4* g1 = (const GAS f32x4*)g_post_mix + 2 * lane; const GAS f32x4* g2 = (const GAS f32x4*)g_pre_ffn + 2 * lane;
            GAS v4u* ob = (GAS v4u*)(OB + (size_t)m * DM) + lane;
            f32x4 v[8][2]; float s = 0.f;
            if (m < MP) {
#pragma unroll
                for (int j = 0; j < 8; ++j) pg8::unpack8(ob[64 * j], v[j][0], v[j][1]);
            } else {
                const GAS v4u* xp = (const GAS v4u*)(XT + (size_t)(m - MP) * DM) + lane;
#pragma unroll
                for (int j = 0; j < 8; ++j) { f32x4 a0, a1; pg8::unpack8(xp[64 * j], a0, a1);
#pragma unroll
                    for (int p = 1; p < 4; ++p) { f32x4 c0, c1; pg8::unpack8(xp[64 * j + (size_t)p * MSMP * DM / 8], c0, c1); a0 = a0 + c0; a1 = a1 + c1; }
                    pg8::unpack8(pg8::pack8(a0, a1), v[j][0], v[j][1]); }
            }
#pragma unroll
            for (int j = 0; j < 8; ++j)
#pragma unroll
                for (int q = 0; q < 2; ++q) s += (v[j][q].x * v[j][q].x + v[j][q].y * v[j][q].y) + (v[j][q].z * v[j][q].z + v[j][q].w * v[j][q].w);
            const float rstd = 1.0f / sqrtf(wave_sum(s) * (1.0f / DM) + EPS);
            s = 0.f;
#pragma unroll
            for (int j = 0; j < 8; ++j)
#pragma unroll
                for (int q = 0; q < 2; ++q) { v[j][q] = xr[128 * j + q] + v[j][q] * rstd * g1[128 * j + q]; s += (v[j][q].x * v[j][q].x + v[j][q].y * v[j][q].y) + (v[j][q].z * v[j][q].z + v[j][q].w * v[j][q].w); }
            const float rstd2 = 1.0f / sqrtf(wave_sum(s) * (1.0f / DM) + EPS);
#pragma unroll
            for (int j = 0; j < 8; ++j) ob[64 * j] = pg8::pack8(v[j][0], v[j][1]);
            float amax = 0.f;
#pragma unroll
            for (int j = 0; j < 8; ++j)
#pragma unroll
                for (int q = 0; q < 2; ++q) { v[j][q] = v[j][q] * rstd2 * g2[128 * j + q];
                    amax = fmaxf(amax, fmaxf(fmaxf(fabsf(v[j][q].x), fabsf(v[j][q].y)), fmaxf(fabsf(v[j][q].z), fabsf(v[j][q].w)))); }
#pragma unroll
            for (int o = 1; o < 64; o <<= 1) amax = fmaxf(amax, __shfl_xor(amax, o));
            const float qs = amax > 0.f ? 127.0f / amax : 0.f;
            if (lane == 0) SA[m] = amax * (1.0f / 127.0f);
            GAS v2u* o8 = (GAS v2u*)(HF8 + (size_t)m * DM) + lane;
#pragma unroll
            for (int j = 0; j < 8; ++j) { v2u o;
                o.x = q8pack(v[j][0] * qs); o.y = q8pack(v[j][1] * qs); o8[64 * j] = o; }
        }
        if (BOTH(7)) GRID_BAR();
    }
    if (IN(8)) {
#if MK_P7_TAIL
        pg8::Gemm g{(const bf16*)HF8, (const bf16*)WT_UP8, M, 2 * DFF, DM / 2}; typedef pg8::RoundsTailOrderT<M, 2 * DFF, DM / 2, 8, 256> SO; SO S; S.init(bx);
        pg8::EpiSwiGluI8 E{HB, (pg8::f32x4*)(ws + WS_R5), SA, SB};
        if (G == 256) pg8::gemm_phase<pg8::EpiSwiGluI8, SO, true, true, pg8::NoHook, true>(lds + RING_OFF, g, S, E);
        if (BOTH(8)) GRID_BAR();
#else
        pg8::Gemm g{HF, WT_UP, M, 2 * DFF, DM}; typedef pg8::StaticOrderT<M, 2 * DFF, DM> SO; SO S; S.init(G, bx);
        pg8::EpiSwiGlu E{HB, (pg8::f32x4*)(ws + WS_R5)};
        pg8::gemm_phase<pg8::EpiSwiGlu, SO, true, true>(lds + RING_OFF, g, S, E);
#endif
    }
#if defined(MK_PROBE_SAMETILE)
    if (IN(9)) {
        struct SameTile { int pm, pn; __device__ __forceinline__ long long next(int i) const { return i < 12 ? pg8::pack_unit(pm, pn, 0, 0, DM / 64) : -1ll; } __device__ __forceinline__ int max_units() const { return 12; } };
        pg8::Gemm g{HF, WT_UP, M, 2 * DFF, DM}; SameTile S{MK_PROBE_SAMETILE ? (bx & 31) : 0, MK_PROBE_SAMETILE ? (bx >> 5) : 0}; pg8::EpiSwiGlu E{HB, (pg8::f32x4*)(ws + WS_R5)};
        pg8::gemm_phase<pg8::EpiSwiGlu, SameTile, true, true>(lds + RING_OFF, g, S, E);
        GRID_BAR();
    }
#endif
    if (IN(9)) {
#if MK_P7_TAIL
        typedef pg8::RoundsTailOrderT<M, 2 * DFF, DM / 2, 8, 256> SO;
        for (int it = bx; it < SO::nTail * 8; it += G) {
            const int tu = it >> 3, ai = (it >> 2) & 1, m = it & 3; const pg8::Unit u = pg8::unpack_unit(SO::WO::map(SO::R * 256 + tu));
            const int wr = wave >> 2, wc = wave & 3, fr = lane & 15, fq = lane >> 4;
            const pg8::u32x4* sp = (const pg8::u32x4*)(ws + WS_R5) + (size_t)(tu * 8) * 16 * 512 + tid;
            pg8::f32x4 v[2][2];
#pragma unroll
            for (int bj = 0; bj < 2; ++bj) { pg8::unpack8(sp[((ai * 2 + bj) * 4 + m) * 512], v[bj][0], v[bj][1]);
#pragma unroll
                for (int p = 1; p < 8; ++p) { pg8::f32x4 c0, c1; pg8::unpack8(sp[((size_t)p * 16 + ((ai * 2 + bj) * 4 + m)) * 512], c0, c1); v[bj][0] = v[bj][0] + c0; v[bj][1] = v[bj][1] + c1; } }
            const int row = u.pm * 256 + wr * 64 + fr + ai * 128 + m * 16, cq = u.pn * 256 + wc * 32 + 8 * fq; const float sa = SA[row];
            const pg8::f32x4 g0 = v[0][0] * (*(const pg8::f32x4*)(SB + cq) * sa), g1 = v[0][1] * (*(const pg8::f32x4*)(SB + cq + 4) * sa);
            const pg8::f32x4 u0 = v[1][0] * (*(const pg8::f32x4*)(SB + cq + 128) * sa), u1 = v[1][1] * (*(const pg8::f32x4*)(SB + cq + 132) * sa);
            const size_t off = (size_t)row * DFF + u.pn * 128 + wc * 32 + 8 * fq;
            *(pg8::u32x4*)(HB + off) = pg8::pack8(g0 * pg8::sigm4(g0) * u0, g1 * pg8::sigm4(g1) * u1);
        }
#endif
        if (BOTH(9)) GRID_BAR();
    }
    if (IN(10)) {
        pg8::Gemm g{HB, WT_DN, M, DM, DFF}; typedef pg8::TailSplitOrderT<MP, M, DM, DFF, 4> SO; SO S; S.init(G, bx);
        pg8::EpiBf16Parts E{FB, XT, MP, MSMP};
        pg8::gemm_phase<pg8::EpiBf16Parts, SO, true, true>(lds + RING_OFF, g, S, E);
        if (BOTH(10)) GRID_BAR();
    }
    if (IN(11)) {
        const float* g_post_ffn = in_ptr(26);
        ROW_LOOP(m, M, M) {
            const GAS f32x4* g3 = (const GAS f32x4*)g_post_ffn + 2 * lane;
            const GAS v4u* ob = (const GAS v4u*)(OB + (size_t)m * DM) + lane; const GAS v4u* fb = (const GAS v4u*)(FB + (size_t)m * DM) + lane;
            GAS f32x4* yo = (GAS f32x4*)(out + OUT_Y + (size_t)m * DM) + 2 * lane;
            f32x4 v[8][2]; float s = 0.f;
            if (m < MP) {
#pragma unroll
                for (int j = 0; j < 8; ++j) pg8::unpack8(fb[64 * j], v[j][0], v[j][1]);
            } else {
                const GAS v4u* xp = (const GAS v4u*)(XT + (size_t)(m - MP) * DM) + lane;
#pragma unroll
                for (int j = 0; j < 8; ++j) { f32x4 a0, a1; pg8::unpack8(xp[64 * j], a0, a1);
#pragma unroll
                    for (int p = 1; p < 4; ++p) { f32x4 c0, c1; pg8::unpack8(xp[64 * j + (size_t)p * MSMP * DM / 8], c0, c1); a0 = a0 + c0; a1 = a1 + c1; }
                    v[j][0] = a0; v[j][1] = a1; }
            }
#pragma unroll
            for (int j = 0; j < 8; ++j)
#pragma unroll
                for (int q = 0; q < 2; ++q) s += (v[j][q].x * v[j][q].x + v[j][q].y * v[j][q].y) + (v[j][q].z * v[j][q].z + v[j][q].w * v[j][q].w);
            const float rstd = 1.0f / sqrtf(wave_sum(s) * (1.0f / DM) + EPS);
#pragma unroll
            for (int j = 0; j < 8; ++j) { f32x4 o0, o1; pg8::unpack8(ob[64 * j], o0, o1);
                yo[128 * j] = o0 + v[j][0] * rstd * g3[128 * j];
                yo[128 * j + 1] = o1 + v[j][1] * rstd * g3[128 * j + 1]; }
        }
    }
#undef ROW_LOOP
#undef IN
#undef BOTH
#undef GRID_BAR
}

extern "C" void kernel_launch(void* const* d_in, const int* in_sizes, int n_in, void* d_out, int out_size, void* d_ws, size_t ws_size, hipStream_t stream) {
    static int grid = 0;
    if (grid == 0) {
        if (n_in != 27 || out_size != (int)OUT_END || ws_size < WS_END) { fprintf(stderr, "kernel_launch: unexpected shapes: n_in %d out %d ws %zu (need %zu)\n", n_in, out_size, ws_size, (size_t)WS_END); grid = -1; return; }
        int dev = 0, cus = 0, per_cu = 0;
        if (hipGetDevice(&dev) != hipSuccess || hipDeviceGetAttribute(&cus, hipDeviceAttributeMultiprocessorCount, dev) != hipSuccess) { grid = -1; return; }
        if (hipFuncSetAttribute((const void*)fwd, hipFuncAttributeMaxDynamicSharedMemorySize, LDS_BYTES) != hipSuccess) { fprintf(stderr, "kernel_launch: hipFuncSetAttribute failed\n"); grid = -1; return; }
        if (hipOccupancyMaxActiveBlocksPerMultiprocessor(&per_cu, (const void*)fwd, NWAVES * 64, LDS_BYTES) != hipSuccess || per_cu < 1) { fprintf(stderr, "kernel_launch: occupancy query says %d\n", per_cu); (void)hipGetLastError(); grid = -1; return; }
        if (cus != 256) { fprintf(stderr, "kernel_launch: built for a 256-CU device, found %d CUs; nothing launched\n", cus); grid = -1; return; }
        grid = cus;
    }
    if (grid < 0) return;
    if (hipMemsetAsync((char*)d_ws + WS_CTL, 0, CTL_ZERO_BYTES, stream) != hipSuccess) return;
    Args a{};
    for (int i = 0; i < 27; ++i) a.in[i] = (const float*)d_in[i];
    a.out = (float*)d_out; a.ws = (unsigned char*)d_ws;
#if defined(MK_PROBE_DUP)
    a.ph_lo = 0; a.ph_hi = MK_PROBE_DUP + 1; hipLaunchKernelGGL(fwd, dim3(grid), dim3(NWAVES * 64), LDS_BYTES, stream, a);
    (void)hipMemsetAsync((char*)d_ws + WS_CTL, 0, CTL_ZERO_BYTES, stream);
    a.ph_lo = MK_PROBE_DUP; a.ph_hi = N_PHASES; hipLaunchKernelGGL(fwd, dim3(grid), dim3(NWAVES * 64), LDS_BYTES, stream, a);
#else
    for (int li = 0; li < N_LAUNCHES; ++li) {
        a.ph_lo = (N_LAUNCHES == 1) ? 0 : li; a.ph_hi = (N_LAUNCHES == 1) ? N_PHASES : li + 1;
        hipLaunchKernelGGL(fwd, dim3(grid), dim3(NWAVES * 64), LDS_BYTES, stream, a);
        if (hipPeekAtLastError() != hipSuccess) { fprintf(stderr, "kernel_launch: launch %d failed\n", li); break; }
    }
#endif
}
```
